# Optimizing an MI355X kernel written in HIP

```python
import math
import jax, jax.numpy as jnp
from jax import lax
import numpy as np

D_MODEL = 1024
BATCH = 32
SEQ = 2048
DEPTH = 2

MIX_WIDTH = D_MODEL
DN_WIDTH = MIX_WIDTH // 2
DN_HEADS = 4
DN_HEAD_DIM = DN_WIDTH // DN_HEADS
CONV_WIDTH = 4
CHUNK = 64
SSM_WIDTH = MIX_WIDTH - DN_WIDTH
SSM_GROUP = 16
SSM_GROUPS = SSM_WIDTH // SSM_GROUP
SSM_STATE = 64
EPS = 1e-6
COL_QKV = 3 * DN_WIDTH
COL_ZDN = COL_QKV + DN_WIDTH
COL_BETA = COL_ZDN + DN_HEADS
COL_ALPHA = COL_BETA + DN_HEADS
COL_U = COL_ALPHA + SSM_WIDTH
IN_COLS = COL_U + SSM_WIDTH

kernel_name = "hybrid_gdn_s5_parallel_heads"


def rms_norm(x, g):
    xf = x.astype(jnp.float32)
    y = xf * lax.rsqrt(jnp.mean(xf * xf, axis=-1, keepdims=True) + EPS)
    return (y * g.astype(jnp.float32)).astype(x.dtype)


def l2_normalize(x):
    return x * lax.rsqrt(jnp.sum(x * x, axis=-1, keepdims=True) + EPS)


def causal_dwconv(x, w):
    c = x.shape[-1]
    return lax.conv_general_dilated(
        x, w[:, None, :].astype(x.dtype), window_strides=(1,),
        padding=[(CONV_WIDTH - 1, 0)],
        dimension_numbers=("NWC", "WIO", "NWC"), feature_group_count=c)


def gated_delta_rule(q, k, v, g, beta):
    bsz, s, h, dk = q.shape
    dv = v.shape[-1]
    n = s // CHUNK
    def chunks(t):
        t = t.reshape((bsz, n, CHUNK, h) + t.shape[3:])
        return jnp.moveaxis(t, 3, 1)
    q = chunks(q * (dk ** -0.5))
    k = chunks(k)
    v = chunks(v)
    gc = jnp.cumsum(chunks(g), axis=-1)
    beta = chunks(beta)
    causal = jnp.tril(jnp.ones((CHUNK, CHUNK), dtype=bool))
    strict = jnp.tril(jnp.ones((CHUNK, CHUNK), dtype=bool), -1)
    diff = gc[..., :, None] - gc[..., None, :]
    decay = jnp.where(causal, jnp.exp(jnp.where(causal, diff, 0.0)), 0.0)
    kb = k * beta[..., None]
    vb = v * beta[..., None]
    a_mat = jnp.where(strict, jnp.einsum("bhncd,bhnsd->bhncs", kb, k) * decay, 0.0)
    lower = a_mat + jnp.eye(CHUNK, dtype=a_mat.dtype)
    rhs = jnp.concatenate([vb, kb * jnp.exp(gc)[..., None]], axis=-1)
    sol = lax.linalg.triangular_solve(lower, rhs, left_side=True, lower=True, unit_diagonal=True)
    u, w = sol[..., :dv], sol[..., dv:]
    intra = jnp.where(causal, jnp.einsum("bhncd,bhnsd->bhncs", q, k) * decay, 0.0)

    def step(state, inp):
        q_i, k_i, u_i, w_i, g_i, a_i = inp
        v_new = u_i - jnp.einsum("bhcd,bhdv->bhcv", w_i, state)
        o = (jnp.einsum("bhcd,bhdv->bhcv", q_i * jnp.exp(g_i)[..., None], state)
             + jnp.einsum("bhcs,bhsv->bhcv", a_i, v_new))
        g_last = g_i[..., -1]
        k_dec = k_i * jnp.exp(g_last[..., None] - g_i)[..., None]
        state = state * jnp.exp(g_last)[..., None, None] + jnp.einsum("bhcd,bhcv->bhdv", k_dec, v_new)
        return state, o

    xs = tuple(jnp.moveaxis(t, 2, 0) for t in (q, k, u, w, gc, intra))
    state0 = jnp.zeros((bsz, h, dk, dv), jnp.float32)
    _, o = lax.scan(step, state0, xs)
    o = jnp.transpose(o, (1, 0, 3, 2, 4))
    return o.reshape(bsz, s, h, dv)


def s5_scan(u, a_re, a_im, b_re, b_im, c_re, c_im, d, log_dt):
    bsz, s, _ = u.shape
    ug = u.reshape(bsz, s, SSM_GROUPS, SSM_GROUP)
    dt = jnp.exp(log_dt.astype(jnp.float32))[:, None]
    a_re = a_re.astype(jnp.float32)
    a_im = a_im.astype(jnp.float32)
    mag = jnp.exp(a_re * dt)
    ang = a_im * dt
    lb_re, lb_im = mag * jnp.cos(ang), mag * jnp.sin(ang)
    den = a_re * a_re + a_im * a_im
    num_re, num_im = lb_re - 1.0, lb_im
    coef_re = (num_re * a_re + num_im * a_im) / den
    coef_im = (num_im * a_re - num_re * a_im) / den
    b_re = b_re.astype(jnp.float32)
    b_im = b_im.astype(jnp.float32)
    bb_re = coef_re[..., None] * b_re - coef_im[..., None] * b_im
    bb_im = coef_re[..., None] * b_im + coef_im[..., None] * b_re
    bu_re = jnp.einsum("bsgh,gph->sbgp", ug, bb_re)
    bu_im = jnp.einsum("bsgh,gph->sbgp", ug, bb_im)
    lam_re = jnp.broadcast_to(lb_re[None, None], (s, 1, SSM_GROUPS, SSM_STATE))
    lam_im = jnp.broadcast_to(lb_im[None, None], (s, 1, SSM_GROUPS, SSM_STATE))

    def combine(e1, e2):
        a1r, a1i, b1r, b1i = e1
        a2r, a2i, b2r, b2i = e2
        return (a2r * a1r - a2i * a1i, a2r * a1i + a2i * a1r,
                a2r * b1r - a2i * b1i + b2r, a2r * b1i + a2i * b1r + b2i)

    _, _, st_re, st_im = lax.associative_scan(combine, (lam_re, lam_im, bu_re, bu_im), axis=0)
    y = (jnp.einsum("sbgp,ghp->bsgh", st_re, c_re.astype(jnp.float32))
         - jnp.einsum("sbgp,ghp->bsgh", st_im, c_im.astype(jnp.float32)))
    return y.reshape(bsz, s, SSM_WIDTH) + d.astype(jnp.float32) * u


def hybrid_layer(x, pre_g, post_g, w_in, conv_w, dn_a_log, dn_dt_bias, dn_norm_g,
                 ssm_a_re, ssm_a_im, ssm_b_re, ssm_b_im, ssm_c_re, ssm_c_im, ssm_d,
                 ssm_log_dt, glu_w, glu_b, w_out):
    bsz, s, _ = x.shape
    h = rms_norm(x, pre_g)
    p = h @ w_in
    qkv = p[..., :COL_QKV]
    z_dn = p[..., COL_QKV:COL_ZDN]
    beta_logit = p[..., COL_ZDN:COL_BETA]
    alpha = p[..., COL_BETA:COL_ALPHA]
    u_ssm = p[..., COL_ALPHA:COL_U]
    z_ssm = p[..., COL_U:]

    qkv = jax.nn.silu(causal_dwconv(qkv, conv_w)).astype(jnp.float32)
    q = l2_normalize(qkv[..., :DN_WIDTH].reshape(bsz, s, DN_HEADS, DN_HEAD_DIM))
    k = l2_normalize(qkv[..., DN_WIDTH:2 * DN_WIDTH].reshape(bsz, s, DN_HEADS, DN_HEAD_DIM))
    v = qkv[..., 2 * DN_WIDTH:].reshape(bsz, s, DN_HEADS, DN_HEAD_DIM)
    beta = jax.nn.sigmoid(beta_logit.astype(jnp.float32))
    g = -jnp.exp(dn_a_log.astype(jnp.float32)) * jax.nn.softplus(
        alpha.astype(jnp.float32) + dn_dt_bias.astype(jnp.float32))
    o = gated_delta_rule(q, k, v, g, beta)
    o = rms_norm(o, dn_norm_g) * jax.nn.silu(
        z_dn.astype(jnp.float32).reshape(bsz, s, DN_HEADS, DN_HEAD_DIM))
    o_dn = o.reshape(bsz, s, DN_WIDTH).astype(x.dtype)

    y = s5_scan(u_ssm.astype(jnp.float32), ssm_a_re, ssm_a_im, ssm_b_re, ssm_b_im,
                ssm_c_re, ssm_c_im, ssm_d, ssm_log_dt)
    y = jax.nn.gelu(y)
    gl = y @ glu_w.astype(jnp.float32) + glu_b.astype(jnp.float32)
    y = gl[..., :SSM_WIDTH] * jax.nn.sigmoid(gl[..., SSM_WIDTH:])
    o_ssm = (y * jax.nn.silu(z_ssm.astype(jnp.float32))).astype(x.dtype)

    mix = jnp.concatenate([o_dn, o_ssm], axis=-1) @ w_out
    return x + rms_norm(mix, post_g)


def setup_inputs(seed: int = 0) -> dict:
    key = jax.random.key(seed)
    ks = jax.random.split(key, 20)
    f32 = jnp.float32
    nrm = lambda k, shp, sc: sc * jax.random.normal(k, shp, f32)
    log_lo, log_hi = math.log(1e-3), math.log(1e-1)
    dn_dt = jnp.exp(jax.random.uniform(ks[6], (DEPTH, DN_HEADS), f32, log_lo, log_hi))
    return {
        "x": jax.random.normal(ks[0], (BATCH, SEQ, D_MODEL), f32),
        "pre_norm_g": 1.0 + nrm(ks[1], (DEPTH, D_MODEL), 0.05),
        "post_norm_g": 1.0 + nrm(ks[2], (DEPTH, D_MODEL), 0.05),
        "w_in": nrm(ks[3], (DEPTH, D_MODEL, IN_COLS), D_MODEL ** -0.5),
        "conv_w": nrm(ks[4], (DEPTH, CONV_WIDTH, COL_QKV), CONV_WIDTH ** -0.5),
        "dn_a_log": jnp.log(jax.random.uniform(ks[5], (DEPTH, DN_HEADS), f32, 1.0, 16.0)),
        "dn_dt_bias": dn_dt + jnp.log(-jnp.expm1(-dn_dt)),
        "dn_norm_g": 1.0 + nrm(ks[7], (DEPTH, DN_HEAD_DIM), 0.05),
        "ssm_a_re": -0.5 + nrm(ks[8], (DEPTH, SSM_GROUPS, SSM_STATE), 0.01),
        "ssm_a_im": math.pi * jnp.arange(SSM_STATE, dtype=f32) + nrm(ks[9], (DEPTH, SSM_GROUPS, SSM_STATE), 0.01),
        "ssm_b_re": nrm(ks[10], (DEPTH, SSM_GROUPS, SSM_STATE, SSM_GROUP), (2 * SSM_GROUP) ** -0.5),
        "ssm_b_im": nrm(ks[11], (DEPTH, SSM_GROUPS, SSM_STATE, SSM_GROUP), (2 * SSM_GROUP) ** -0.5),
        "ssm_c_re": nrm(ks[12], (DEPTH, SSM_GROUPS, SSM_GROUP, SSM_STATE), SSM_STATE ** -0.5),
        "ssm_c_im": nrm(ks[13], (DEPTH, SSM_GROUPS, SSM_GROUP, SSM_STATE), SSM_STATE ** -0.5),
        "ssm_d": nrm(ks[14], (DEPTH, SSM_WIDTH), 1.0),
        "ssm_log_dt": jax.random.uniform(ks[15], (DEPTH, SSM_GROUPS), f32, log_lo, log_hi),
        "glu_w": nrm(ks[16], (DEPTH, SSM_WIDTH, 2 * SSM_WIDTH), SSM_WIDTH ** -0.5),
        "glu_b": nrm(ks[17], (DEPTH, 2 * SSM_WIDTH), 0.01),
        "w_out": nrm(ks[18], (DEPTH, MIX_WIDTH, D_MODEL), MIX_WIDTH ** -0.5),
    }


def reference(x, pre_norm_g, post_norm_g, w_in, conv_w, dn_a_log, dn_dt_bias, dn_norm_g,
              ssm_a_re, ssm_a_im, ssm_b_re, ssm_b_im, ssm_c_re, ssm_c_im, ssm_d,
              ssm_log_dt, glu_w, glu_b, w_out):
    for l in range(DEPTH):
        x = hybrid_layer(x, pre_norm_g[l], post_norm_g[l], w_in[l], conv_w[l], dn_a_log[l],
                         dn_dt_bias[l], dn_norm_g[l], ssm_a_re[l], ssm_a_im[l], ssm_b_re[l],
                         ssm_b_im[l], ssm_c_re[l], ssm_c_im[l], ssm_d[l], ssm_log_dt[l],
                         glu_w[l], glu_b[l], w_out[l])
    return x
```

```cpp
#include <hip/hip_runtime.h>
#include <hip/hip_cooperative_groups.h>
#include <cstdio>
#include <cstdint>
namespace cg = cooperative_groups;

constexpr int D = 1024, BATCH = 32, SEQ = 2048, DEPTH = 2, T = BATCH * SEQ;
constexpr int NH = 4, HD = 128, DNW = 512, QKV = 1536;
constexpr int NG = 32, SGC = 16, SP = 64, SW = 512;
constexpr int INC = 3080;
constexpr int C_ZDN = 1536, C_BETA = 2048, C_ALPHA = 2052, C_U = 2056, C_ZS = 2568;
constexpr float EPS = 1e-6f;
constexpr int NTHREADS = 512, NWAVES = 8;
constexpr int LDS_BYTES = 147456;

typedef unsigned short bf16;
__device__ __forceinline__ float bf2f(bf16 v) { return __uint_as_float(((unsigned)v) << 16); }
__device__ __forceinline__ bf16 f2bf(float f) { unsigned u = __float_as_uint(f); return (bf16)((u + 0x7fffu + ((u >> 16) & 1u)) >> 16); }
__device__ __forceinline__ float siluf(float x) { return x / (1.f + __expf(-x)); }
__device__ __forceinline__ float sigmf(float x) { return 1.f / (1.f + __expf(-x)); }
__device__ __forceinline__ float softplusf(float x) { return x > 20.f ? x : log1pf(__expf(x)); }
__device__ __forceinline__ float gelu_tanh(float x) { const float u = 0.7978845608028654f * (x + 0.044715f * x * x * x); return 0.5f * x * (1.f + tanhf(u)); }
__device__ __forceinline__ float wave_sum(float v) {
#pragma unroll
    for (int o = 1; o < 64; o <<= 1) v += __shfl_xor(v, o);
    return v;
}

constexpr size_t MiB = 1u << 20;
constexpr size_t WS_CTL = 0;
constexpr size_t WS_BETA = 22 * MiB, WS_GLOG = 23 * MiB, WS_SSQ = 24 * MiB;
constexpr size_t WS_XN = 32 * MiB;
constexpr size_t WS_QKV = 160 * MiB;
constexpr size_t WS_MIXO = 160 * MiB, WS_YS = 560 * MiB;
constexpr size_t WS_ZDN = 352 * MiB, WS_ZS = 416 * MiB;
constexpr size_t WS_UGX = 480 * MiB;
constexpr size_t WS_END = 944 * MiB;
constexpr int UGX_LD = 1152;

struct Args { const float* in[19]; float* out; unsigned char* ws; int lo, hi; };

struct Ptrs {
    const float *x, *pre_g, *post_g, *w_in, *conv_w, *a_log, *dt_bias, *dn_g, *a_re, *a_im, *b_re, *b_im, *c_re, *c_im, *sd, *log_dt, *glu_w, *glu_b, *w_out;
    float* out;
    bf16 *XN, *MIXIN, *QKVR, *MIXO, *YS, *ZDN, *ZS, *UGX;
    float *BETA, *GLOG, *SSQ;
};

__device__ __forceinline__ void p0_norm(const Ptrs& P, int mode, const float* xsrc, float* xdst, const float* postg, const float* preg) {
    const int lane = threadIdx.x & 63, wave = threadIdx.x >> 6;
    const int gw = blockIdx.x * NWAVES + wave, ngw = gridDim.x * NWAVES;
    for (int m = gw; m < T; m += ngw) {
        float4 v[4];
        const float4* xr = (const float4*)(xsrc + (size_t)m * D) + lane;
#pragma unroll
        for (int j = 0; j < 4; ++j) v[j] = xr[64 * j];
        if (mode != 0) {
            float ss = 0.f;
            if (lane < 16) ss = P.SSQ[(size_t)m * 16 + lane];
            ss = wave_sum(ss);
            const float rinv = rsqrtf(ss * (1.f / D) + EPS);
            const uint2* mr = (const uint2*)(P.MIXO + (size_t)m * D) + lane;
#pragma unroll
            for (int j = 0; j < 4; ++j) {
                const uint2 w = mr[64 * j];
                const float4 g = ((const float4*)postg)[lane + 64 * j];
                v[j].x += bf2f((bf16)(w.x & 0xffff)) * rinv * g.x; v[j].y += bf2f((bf16)(w.x >> 16)) * rinv * g.y;
                v[j].z += bf2f((bf16)(w.y & 0xffff)) * rinv * g.z; v[j].w += bf2f((bf16)(w.y >> 16)) * rinv * g.w;
            }
            float4* xo = (float4*)(xdst + (size_t)m * D) + lane;
#pragma unroll
            for (int j = 0; j < 4; ++j) xo[64 * j] = v[j];
        }
        if (mode != 2) {
            float s = 0.f;
#pragma unroll
            for (int j = 0; j < 4; ++j) s += v[j].x * v[j].x + v[j].y * v[j].y + v[j].z * v[j].z + v[j].w * v[j].w;
            s = wave_sum(s);
            const float rinv = rsqrtf(s * (1.f / D) + EPS);
            uint2* xo = (uint2*)(P.XN + (size_t)m * D) + lane;
#pragma unroll
            for (int j = 0; j < 4; ++j) {
                const float4 g = ((const float4*)preg)[lane + 64 * j];
                uint2 w;
                w.x = (unsigned)f2bf(v[j].x * rinv * g.x) | ((unsigned)f2bf(v[j].y * rinv * g.y) << 16);
                w.y = (unsigned)f2bf(v[j].z * rinv * g.z) | ((unsigned)f2bf(v[j].w * rinv * g.w) << 16);
                xo[64 * j] = w;
            }
        }
    }
}

template <int MODE>
__device__ __forceinline__ void ngemm(unsigned char* ldsb, const Ptrs& P, int l, const bf16* A, int lda, const float* W, int N, int Ncols, int K) {
    float* As = (float*)ldsb;
    float* Bs = As + 128 * 36;
    float* Bs2 = Bs + 32 * 64;
    const int tid = threadIdx.x, tx = tid & 63, ty = tid >> 6, lane = tid & 63;
    const int nct = (Ncols + 63) / 64, nrt = T / 128;
    for (int tile = blockIdx.x; tile < nrt * nct; tile += gridDim.x) {
        const int rt = tile / nct, ct = tile % nct;
        const int row0 = rt * 128, col0 = ct * 64;
        float acc[16], acc2[16];
#pragma unroll
        for (int r = 0; r < 16; ++r) { acc[r] = 0.f; acc2[r] = 0.f; }
        for (int k0 = 0; k0 < K; k0 += 32) {
            {
                const int r = tid >> 2, kq = (tid & 3) * 8;
                const uint4 v = *(const uint4*)(A + (size_t)(row0 + r) * lda + k0 + kq);
                float* d = As + r * 36 + kq;
                d[0] = bf2f((bf16)(v.x & 0xffff)); d[1] = bf2f((bf16)(v.x >> 16));
                d[2] = bf2f((bf16)(v.y & 0xffff)); d[3] = bf2f((bf16)(v.y >> 16));
                d[4] = bf2f((bf16)(v.z & 0xffff)); d[5] = bf2f((bf16)(v.z >> 16));
                d[6] = bf2f((bf16)(v.w & 0xffff)); d[7] = bf2f((bf16)(v.w >> 16));
            }
            {
                const int k = tid >> 4, c4 = (tid & 15) * 4;
#pragma unroll
                for (int j = 0; j < 4; ++j) {
                    const int col = col0 + c4 + j;
                    Bs[k * 64 + c4 + j] = col < Ncols ? W[(size_t)(k0 + k) * N + col] : 0.f;
                    if (MODE == 1) Bs2[k * 64 + c4 + j] = W[(size_t)(k0 + k) * N + col + 512];
                }
            }
            __syncthreads();
#pragma unroll 1
            for (int kk = 0; kk < 32; kk += 4) {
                const float b0 = Bs[(kk + 0) * 64 + tx], b1 = Bs[(kk + 1) * 64 + tx], b2 = Bs[(kk + 2) * 64 + tx], b3 = Bs[(kk + 3) * 64 + tx];
                float c0 = 0.f, c1 = 0.f, c2 = 0.f, c3 = 0.f;
                if (MODE == 1) { c0 = Bs2[(kk + 0) * 64 + tx]; c1 = Bs2[(kk + 1) * 64 + tx]; c2 = Bs2[(kk + 2) * 64 + tx]; c3 = Bs2[(kk + 3) * 64 + tx]; }
#pragma unroll
                for (int r = 0; r < 16; ++r) {
                    const float4 a4 = *(const float4*)(As + (ty * 16 + r) * 36 + kk);
                    acc[r] += a4.x * b0 + a4.y * b1 + a4.z * b2 + a4.w * b3;
                    if (MODE == 1) acc2[r] += a4.x * c0 + a4.y * c1 + a4.z * c2 + a4.w * c3;
                }
            }
            __syncthreads();
        }
        const int col = col0 + tx;
#pragma unroll
        for (int r = 0; r < 16; ++r) {
            const int row = row0 + ty * 16 + r;
            const float v = acc[r];
            if (MODE == 0) {
                if (col < Ncols) {
                    if (col < C_ZDN) P.QKVR[(size_t)row * QKV + col] = f2bf(v);
                    else if (col < C_BETA) P.ZDN[(size_t)row * 512 + (col - C_ZDN)] = f2bf(siluf(v));
                    else if (col < C_ALPHA) P.BETA[(size_t)row * 4 + (col - C_BETA)] = sigmf(v);
                    else if (col < C_U) { const int h = col - C_ALPHA; P.GLOG[(size_t)row * 4 + h] = -__expf(P.a_log[l * 4 + h]) * softplusf(v + P.dt_bias[l * 4 + h]); }
                    else if (col < C_ZS) { const int c = col - C_U, g = c >> 4, hh = c & 15, b = row >> 11, t = row & 2047;
                        P.UGX[((size_t)g * 1024 + b * 32 + (t >> 6)) * UGX_LD + (t & 63) * 16 + hh] = f2bf(v); }
                    else P.ZS[(size_t)row * 512 + (col - C_ZS)] = f2bf(siluf(v));
                }
            } else if (MODE == 1) {
                const float val = v + P.glu_b[l * 1024 + col], gate = acc2[r] + P.glu_b[l * 1024 + 512 + col];
                const float o = val * sigmf(gate) * bf2f(P.ZS[(size_t)row * 512 + col]);
                P.MIXIN[(size_t)row * D + 512 + col] = f2bf(o);
            } else {
                P.MIXO[(size_t)row * D + col] = f2bf(v);
                const float s = wave_sum(v * v);
                if (lane == 0) P.SSQ[(size_t)row * 16 + ct] = s;
            }
        }
    }
}

__device__ __forceinline__ void dn_naive(unsigned char* ldsb, const Ptrs& P, int l) {
    float* qs = (float*)ldsb; float* ks = qs + 128; float* vs = ks + 128; float* red = vs + 128; float* part = red + 16; float* part2 = part + 512;
    const int tid = threadIdx.x, wave = tid >> 6, lane = tid & 63;
    const int nb = gridDim.x / 2;
    if ((int)blockIdx.x >= nb) return;
    for (int item = blockIdx.x; item < BATCH * NH; item += nb) {
        const int b = item / NH, h = item % NH;
        float S[32];
#pragma unroll
        for (int i = 0; i < 32; ++i) S[i] = 0.f;
        const int dv = tid & 127, grp = tid >> 7;
        const int pid = tid >> 7, c = tid & 127;
        const int ch = (pid < 3 ? pid : 0) * 512 + h * 128 + c;
        float cw[4];
#pragma unroll
        for (int j = 0; j < 4; ++j) cw[j] = P.conv_w[(size_t)(l * 4 + j) * QKV + ch];
        const float ng = P.dn_g[l * 128 + dv];
        for (int t = 0; t < SEQ; ++t) {
            const int row = b * SEQ + t;
            float val = 0.f;
            if (tid < 384) {
                float a = 0.f;
#pragma unroll
                for (int j = 0; j < 4; ++j) { const int tt = t - 3 + j; if (tt >= 0) a += cw[j] * bf2f(P.QKVR[(size_t)(row - 3 + j) * QKV + ch]); }
                val = siluf(a);
                const float ss = wave_sum(val * val);
                if (lane == 0) red[wave] = ss;
            }
            __syncthreads();
            if (tid < 384) {
                if (pid < 2) { const float tot = red[2 * pid] + red[2 * pid + 1]; val *= rsqrtf(tot + EPS); if (pid == 0) val *= 0.08838834764831845f; }
                (pid == 0 ? qs : (pid == 1 ? ks : vs))[c] = val;
            }
            __syncthreads();
            const float g = P.GLOG[(size_t)row * 4 + h], beta = P.BETA[(size_t)row * 4 + h];
            const float eg = __expf(g);
            float pp = 0.f;
#pragma unroll
            for (int i = 0; i < 32; ++i) { S[i] *= eg; pp += ks[grp * 32 + i] * S[i]; }
            part[grp * 128 + dv] = pp;
            __syncthreads();
            const float pred = part[dv] + part[128 + dv] + part[256 + dv] + part[384 + dv];
            const float delta = beta * (vs[dv] - pred);
            float op = 0.f;
#pragma unroll
            for (int i = 0; i < 32; ++i) { S[i] += ks[grp * 32 + i] * delta; op += qs[grp * 32 + i] * S[i]; }
            part2[grp * 128 + dv] = op;
            __syncthreads();
            float o = 0.f;
            if (tid < 128) {
                o = part2[tid] + part2[128 + tid] + part2[256 + tid] + part2[384 + tid];
                const float ss = wave_sum(o * o);
                if (lane == 0) red[8 + wave] = ss;
            }
            __syncthreads();
            if (tid < 128) {
                const float rinv = rsqrtf((red[8] + red[9]) * (1.f / 128.f) + EPS);
                const float z = bf2f(P.ZDN[(size_t)row * 512 + h * 128 + tid]);
                P.MIXIN[(size_t)row * D + h * 128 + tid] = f2bf(o * rinv * ng * z);
            }
        }
        __syncthreads();
    }
}

__device__ __forceinline__ void s5_naive(const Ptrs& P, int l) {
    const int nb = gridDim.x / 2;
    if ((int)blockIdx.x < nb) return;
    const int lane = threadIdx.x & 63, wave = threadIdx.x >> 6;
    const int gw = ((int)blockIdx.x - nb) * NWAVES + wave, ngw = ((int)gridDim.x - nb) * NWAVES;
    for (int item = gw; item < BATCH * NG; item += ngw) {
        const int b = item / NG, g = item % NG, p = lane;
        const float dt = __expf(P.log_dt[l * NG + g]);
        const float are = P.a_re[(size_t)(l * NG + g) * SP + p], aim = P.a_im[(size_t)(l * NG + g) * SP + p];
        const float mag = __expf(are * dt), ang = aim * dt;
        float sn, cs; sincosf(ang, &sn, &cs);
        const float lr = mag * cs, li = mag * sn;
        const float den = are * are + aim * aim, nr = lr - 1.f, ni = li;
        const float cfr = (nr * are + ni * aim) / den, cfi = (ni * are - nr * aim) / den;
        float bbr[16], bbi[16], cr[16], ci[16];
#pragma unroll
        for (int hh = 0; hh < 16; ++hh) {
            const float br = P.b_re[((size_t)(l * NG + g) * SP + p) * 16 + hh], bi = P.b_im[((size_t)(l * NG + g) * SP + p) * 16 + hh];
            bbr[hh] = cfr * br - cfi * bi; bbi[hh] = cfr * bi + cfi * br;
            cr[hh] = P.c_re[((size_t)(l * NG + g) * 16 + hh) * SP + p]; ci[hh] = P.c_im[((size_t)(l * NG + g) * 16 + hh) * SP + p];
        }
        const float dd = lane < 16 ? P.sd[l * SW + g * 16 + lane] : 0.f;
        float xr = 0.f, xi = 0.f;
        for (int t = 0; t < SEQ; ++t) {
            const int row = b * SEQ + t;
            const bf16* up = P.UGX + ((size_t)g * 1024 + b * 32 + (t >> 6)) * UGX_LD + (t & 63) * 16;
            const uint4 u0 = *(const uint4*)up, u1 = *(const uint4*)(up + 8);
            float u[16];
            u[0] = bf2f((bf16)(u0.x & 0xffff)); u[1] = bf2f((bf16)(u0.x >> 16)); u[2] = bf2f((bf16)(u0.y & 0xffff)); u[3] = bf2f((bf16)(u0.y >> 16));
            u[4] = bf2f((bf16)(u0.z & 0xffff)); u[5] = bf2f((bf16)(u0.z >> 16)); u[6] = bf2f((bf16)(u0.w & 0xffff)); u[7] = bf2f((bf16)(u0.w >> 16));
            u[8] = bf2f((bf16)(u1.x & 0xffff)); u[9] = bf2f((bf16)(u1.x >> 16)); u[10] = bf2f((bf16)(u1.y & 0xffff)); u[11] = bf2f((bf16)(u1.y >> 16));
            u[12] = bf2f((bf16)(u1.z & 0xffff)); u[13] = bf2f((bf16)(u1.z >> 16)); u[14] = bf2f((bf16)(u1.w & 0xffff)); u[15] = bf2f((bf16)(u1.w >> 16));
            float bur = 0.f, bui = 0.f;
#pragma unroll
            for (int hh = 0; hh < 16; ++hh) { bur += bbr[hh] * u[hh]; bui += bbi[hh] * u[hh]; }
            const float nxr = lr * xr - li * xi + bur, nxi = lr * xi + li * xr + bui;
            xr = nxr; xi = nxi;
            float my = 0.f, myu = 0.f;
#pragma unroll
            for (int hh = 0; hh < 16; ++hh) {
                const float y = wave_sum(cr[hh] * xr - ci[hh] * xi);
                if (lane == hh) { my = y; myu = u[hh]; }
            }
            if (lane < 16) P.YS[(size_t)row * SW + g * 16 + lane] = f2bf(gelu_tanh(my + dd * myu));
        }
    }
}

__global__ void __launch_bounds__(NTHREADS, 2) fwd(Args a) {
    extern __shared__ __attribute__((aligned(16))) unsigned char lds[];
    cg::grid_group grid = cg::this_grid();
    Ptrs P;
    P.x = a.in[0]; P.pre_g = a.in[1]; P.post_g = a.in[2]; P.w_in = a.in[3]; P.conv_w = a.in[4]; P.a_log = a.in[5]; P.dt_bias = a.in[6]; P.dn_g = a.in[7];
    P.a_re = a.in[8]; P.a_im = a.in[9]; P.b_re = a.in[10]; P.b_im = a.in[11]; P.c_re = a.in[12]; P.c_im = a.in[13]; P.sd = a.in[14]; P.log_dt = a.in[15];
    P.glu_w = a.in[16]; P.glu_b = a.in[17]; P.w_out = a.in[18]; P.out = a.out;
    unsigned char* ws = a.ws;
    P.XN = (bf16*)(ws + WS_XN); P.MIXIN = P.XN; P.QKVR = (bf16*)(ws + WS_QKV); P.MIXO = (bf16*)(ws + WS_MIXO); P.YS = (bf16*)(ws + WS_YS);
    P.ZDN = (bf16*)(ws + WS_ZDN); P.ZS = (bf16*)(ws + WS_ZS); P.UGX = (bf16*)(ws + WS_UGX);
    P.BETA = (float*)(ws + WS_BETA); P.GLOG = (float*)(ws + WS_GLOG); P.SSQ = (float*)(ws + WS_SSQ);
    for (int ph = a.lo; ph < a.hi; ++ph) {
        const int l = ph / 5, s = ph % 5;
        if (ph == 5 * DEPTH) {
            p0_norm(P, 2, P.out, P.out, P.post_g + (DEPTH - 1) * D, nullptr);
        } else if (s == 0) {
            if (l == 0) p0_norm(P, 0, P.x, nullptr, nullptr, P.pre_g);
            else p0_norm(P, 1, l == 1 ? P.x : P.out, P.out, P.post_g + (l - 1) * D, P.pre_g + l * D);
        } else if (s == 1) {
            ngemm<0>(lds, P, l, P.XN, D, P.w_in + (size_t)l * D * INC, INC, INC, D);
        } else if (s == 2) {
            dn_naive(lds, P, l);
            s5_naive(P, l);
        } else if (s == 3) {
            ngemm<1>(lds, P, l, P.YS, SW, P.glu_w + (size_t)l * SW * 1024, 1024, 512, SW);
        } else {
            ngemm<2>(lds, P, l, P.MIXIN, D, P.w_out + (size_t)l * D * D, D, D, D);
        }
        if (ph + 1 < a.hi) grid.sync();
    }
}

extern "C" void kernel_launch(void* const* d_in, const int* in_sizes, int n_in, void* d_out, int out_size, void* d_ws, size_t ws_size, hipStream_t stream) {
    static int grid = 0;
    if (grid == 0) {
        if (n_in != 19 || in_sizes[0] != T * D || out_size != T * D || ws_size < WS_END) {
            fprintf(stderr, "kernel_launch: unexpected shapes/workspace: n_in %d in0 %d out %d ws %zu (need %zu)\n", n_in, n_in > 0 ? in_sizes[0] : -1, out_size, ws_size, (size_t)WS_END);
            grid = -1; return;
        }
        int dev = 0, cus = 0, per_cu = 0;
        hipGetDevice(&dev);
        hipDeviceGetAttribute(&cus, hipDeviceAttributeMultiprocessorCount, dev);
        hipFuncSetAttribute((const void*)fwd, hipFuncAttributeMaxDynamicSharedMemorySize, LDS_BYTES);
        hipOccupancyMaxActiveBlocksPerMultiprocessor(&per_cu, (const void*)fwd, NTHREADS, LDS_BYTES);
        if (per_cu < 1) { fprintf(stderr, "kernel_launch: occupancy query says %d blocks/CU\n", per_cu); per_cu = 1; }
        (void)hipGetLastError();
        grid = cus;
        fprintf(stderr, "kernel_launch: cus %d per_cu %d grid %d ws %zu\n", cus, per_cu, grid, ws_size);
    }
    if (grid < 0) return;
    Args a{};
    for (int i = 0; i < 19; ++i) a.in[i] = (const float*)d_in[i];
    a.out = (float*)d_out; a.ws = (unsigned char*)d_ws; a.lo = 0; a.hi = 5 * DEPTH + 1;
    void* args[] = {&a};
    hipError_t e = hipLaunchCooperativeKernel((const void*)fwd, dim3(grid), dim3(NTHREADS), args, LDS_BYTES, stream);
    if (e != hipSuccess) fprintf(stderr, "cooperative launch failed: %s (grid %d)\n", hipGetErrorString(e), grid);
}
```

```cpp
#include <hip/hip_runtime.h>
#include <hip/hip_cooperative_groups.h>
#include <cstdio>
#include <cstdint>
namespace cg = cooperative_groups;
#ifndef FAST_P1
#define FAST_P1 1
#endif
#ifndef FAST_P3
#define FAST_P3 1
#endif
#ifndef FAST_P4
#define FAST_P4 1
#endif

constexpr int D = 1024, BATCH = 32, SEQ = 2048, DEPTH = 2, T = BATCH * SEQ;
constexpr int NH = 4, HD = 128, DNW = 512, QKV = 1536;
constexpr int NG = 32, SGC = 16, SP = 64, SW = 512;
constexpr int INC = 3080;
constexpr int C_ZDN = 1536, C_BETA = 2048, C_ALPHA = 2052, C_U = 2056, C_ZS = 2568;
constexpr float EPS = 1e-6f;
constexpr int NTHREADS = 512, NWAVES = 8;
constexpr int LDS_BYTES = 147456;

typedef unsigned short bf16;
__device__ __forceinline__ float bf2f(bf16 v) { return __uint_as_float(((unsigned)v) << 16); }
__device__ __forceinline__ bf16 f2bf(float f) { unsigned u = __float_as_uint(f); return (bf16)((u + 0x7fffu + ((u >> 16) & 1u)) >> 16); }
__device__ __forceinline__ float siluf(float x) { return x / (1.f + __expf(-x)); }
__device__ __forceinline__ float sigmf(float x) { return 1.f / (1.f + __expf(-x)); }
__device__ __forceinline__ float softplusf(float x) { return x > 20.f ? x : log1pf(__expf(x)); }
__device__ __forceinline__ float gelu_tanh(float x) { const float u = 0.7978845608028654f * (x + 0.044715f * x * x * x); return 0.5f * x * (1.f + tanhf(u)); }
__device__ __forceinline__ int opaque_tid() { int t = threadIdx.x; asm volatile("" : "+v"(t)); return t; }
__device__ __forceinline__ float wave_sum(float v) {
#pragma unroll
    for (int o = 1; o < 64; o <<= 1) v += __shfl_xor(v, o);
    return v;
}

constexpr size_t MiB = 1u << 20;
constexpr size_t WS_CTL = 0;
constexpr size_t WS_WIN = 2 * MiB, WS_WGLU = 16 * MiB, WS_WOUT = 18 * MiB;
constexpr size_t WS_BETA = 22 * MiB, WS_GLOG = 23 * MiB, WS_SSQ = 24 * MiB;
constexpr size_t WS_XN = 32 * MiB;
constexpr size_t WS_QKV = 160 * MiB;
constexpr size_t WS_MIXO = 160 * MiB, WS_YS = 560 * MiB;
constexpr size_t WS_ZDN = 352 * MiB, WS_ZS = 416 * MiB;
constexpr size_t WS_UGX = 480 * MiB;
constexpr size_t WS_END = 944 * MiB;
constexpr int UGX_LD = 1152;

struct Args { const float* in[19]; float* out; unsigned char* ws; int lo, hi; };

struct Ptrs {
    const float *x, *pre_g, *post_g, *w_in, *conv_w, *a_log, *dt_bias, *dn_g, *a_re, *a_im, *b_re, *b_im, *c_re, *c_im, *sd, *log_dt, *glu_w, *glu_b, *w_out;
    float* out;
    bf16 *XN, *MIXIN, *QKVR, *MIXO, *YS, *ZDN, *ZS, *UGX;
    float *BETA, *GLOG, *SSQ;
};

__device__ __forceinline__ void p0_norm(const Ptrs& P, int mode, const float* xsrc, float* xdst, const float* postg, const float* preg) {
    const int tid_ = opaque_tid(); const int lane = tid_ & 63, wave = tid_ >> 6;
    const int gw = blockIdx.x * NWAVES + wave, ngw = gridDim.x * NWAVES;
    for (int m = gw; m < T; m += ngw) {
        float4 v[4];
        const float4* xr = (const float4*)(xsrc + (size_t)m * D) + lane;
#pragma unroll
        for (int j = 0; j < 4; ++j) v[j] = xr[64 * j];
        if (mode != 0) {
            float ss = 0.f;
            if (lane < 16) ss = P.SSQ[(size_t)m * 16 + lane];
            ss = wave_sum(ss);
            const float rinv = rsqrtf(ss * (1.f / D) + EPS);
            const uint2* mr = (const uint2*)(P.MIXO + (size_t)m * D) + lane;
#pragma unroll
            for (int j = 0; j < 4; ++j) {
                const uint2 w = mr[64 * j];
                const float4 g = ((const float4*)postg)[lane + 64 * j];
                v[j].x += bf2f((bf16)(w.x & 0xffff)) * rinv * g.x; v[j].y += bf2f((bf16)(w.x >> 16)) * rinv * g.y;
                v[j].z += bf2f((bf16)(w.y & 0xffff)) * rinv * g.z; v[j].w += bf2f((bf16)(w.y >> 16)) * rinv * g.w;
            }
            float4* xo = (float4*)(xdst + (size_t)m * D) + lane;
#pragma unroll
            for (int j = 0; j < 4; ++j) xo[64 * j] = v[j];
        }
        if (mode != 2) {
            float s = 0.f;
#pragma unroll
            for (int j = 0; j < 4; ++j) s += v[j].x * v[j].x + v[j].y * v[j].y + v[j].z * v[j].z + v[j].w * v[j].w;
            s = wave_sum(s);
            const float rinv = rsqrtf(s * (1.f / D) + EPS);
            uint2* xo = (uint2*)(P.XN + (size_t)m * D) + lane;
#pragma unroll
            for (int j = 0; j < 4; ++j) {
                const float4 g = ((const float4*)preg)[lane + 64 * j];
                uint2 w;
                w.x = (unsigned)f2bf(v[j].x * rinv * g.x) | ((unsigned)f2bf(v[j].y * rinv * g.y) << 16);
                w.y = (unsigned)f2bf(v[j].z * rinv * g.z) | ((unsigned)f2bf(v[j].w * rinv * g.w) << 16);
                xo[64 * j] = w;
            }
        }
    }
}

template <int MODE>
__device__ __forceinline__ void ngemm(unsigned char* ldsb, const Ptrs& P, int l, const bf16* A, int lda, const float* W, int N, int Ncols, int K) {
    float* As = (float*)ldsb;
    float* Bs = As + 128 * 36;
    float* Bs2 = Bs + 32 * 64;
    const int tid = opaque_tid(), tx = tid & 63, ty = tid >> 6, lane = tid & 63;
    const int nct = (Ncols + 63) / 64, nrt = T / 128;
    for (int tile = blockIdx.x; tile < nrt * nct; tile += gridDim.x) {
        const int rt = tile / nct, ct = tile % nct;
        const int row0 = rt * 128, col0 = ct * 64;
        float acc[16], acc2[16];
#pragma unroll
        for (int r = 0; r < 16; ++r) { acc[r] = 0.f; acc2[r] = 0.f; }
        for (int k0 = 0; k0 < K; k0 += 32) {
            {
                const int r = tid >> 2, kq = (tid & 3) * 8;
                const uint4 v = *(const uint4*)(A + (size_t)(row0 + r) * lda + k0 + kq);
                float* d = As + r * 36 + kq;
                d[0] = bf2f((bf16)(v.x & 0xffff)); d[1] = bf2f((bf16)(v.x >> 16));
                d[2] = bf2f((bf16)(v.y & 0xffff)); d[3] = bf2f((bf16)(v.y >> 16));
                d[4] = bf2f((bf16)(v.z & 0xffff)); d[5] = bf2f((bf16)(v.z >> 16));
                d[6] = bf2f((bf16)(v.w & 0xffff)); d[7] = bf2f((bf16)(v.w >> 16));
            }
            {
                const int k = tid >> 4, c4 = (tid & 15) * 4;
#pragma unroll
                for (int j = 0; j < 4; ++j) {
                    const int col = col0 + c4 + j;
                    Bs[k * 64 + c4 + j] = col < Ncols ? W[(size_t)(k0 + k) * N + col] : 0.f;
                    if (MODE == 1) Bs2[k * 64 + c4 + j] = W[(size_t)(k0 + k) * N + col + 512];
                }
            }
            __syncthreads();
#pragma unroll 1
            for (int kk = 0; kk < 32; kk += 4) {
                const float b0 = Bs[(kk + 0) * 64 + tx], b1 = Bs[(kk + 1) * 64 + tx], b2 = Bs[(kk + 2) * 64 + tx], b3 = Bs[(kk + 3) * 64 + tx];
                float c0 = 0.f, c1 = 0.f, c2 = 0.f, c3 = 0.f;
                if (MODE == 1) { c0 = Bs2[(kk + 0) * 64 + tx]; c1 = Bs2[(kk + 1) * 64 + tx]; c2 = Bs2[(kk + 2) * 64 + tx]; c3 = Bs2[(kk + 3) * 64 + tx]; }
#pragma unroll
                for (int r = 0; r < 16; ++r) {
                    const float4 a4 = *(const float4*)(As + (ty * 16 + r) * 36 + kk);
                    acc[r] += a4.x * b0 + a4.y * b1 + a4.z * b2 + a4.w * b3;
                    if (MODE == 1) acc2[r] += a4.x * c0 + a4.y * c1 + a4.z * c2 + a4.w * c3;
                }
            }
            __syncthreads();
        }
        const int col = col0 + tx;
#pragma unroll
        for (int r = 0; r < 16; ++r) {
            const int row = row0 + ty * 16 + r;
            const float v = acc[r];
            if (MODE == 0) {
                if (col < Ncols) {
                    if (col < C_ZDN) P.QKVR[(size_t)row * QKV + col] = f2bf(v);
                    else if (col < C_BETA) P.ZDN[(size_t)row * 512 + (col - C_ZDN)] = f2bf(siluf(v));
                    else if (col < C_ALPHA) P.BETA[(size_t)row * 4 + (col - C_BETA)] = sigmf(v);
                    else if (col < C_U) { const int h = col - C_ALPHA; P.GLOG[(size_t)row * 4 + h] = -__expf(P.a_log[l * 4 + h]) * softplusf(v + P.dt_bias[l * 4 + h]); }
                    else if (col < C_ZS) { const int c = col - C_U, g = c >> 4, hh = c & 15, b = row >> 11, t = row & 2047;
                        P.UGX[((size_t)g * 1024 + b * 32 + (t >> 6)) * UGX_LD + (t & 63) * 16 + hh] = f2bf(v); }
                    else P.ZS[(size_t)row * 512 + (col - C_ZS)] = f2bf(siluf(v));
                }
            } else if (MODE == 1) {
                const float val = v + P.glu_b[l * 1024 + col], gate = acc2[r] + P.glu_b[l * 1024 + 512 + col];
                const float o = val * sigmf(gate) * bf2f(P.ZS[(size_t)row * 512 + col]);
                P.MIXIN[(size_t)row * D + 512 + col] = f2bf(o);
            } else {
                P.MIXO[(size_t)row * D + col] = f2bf(v);
                const float s = wave_sum(v * v);
                if (lane == 0) P.SSQ[(size_t)row * 16 + ct] = s;
            }
        }
    }
}

__device__ __forceinline__ void dn_naive(unsigned char* ldsb, const Ptrs& P, int l) {
    float* qs = (float*)ldsb; float* ks = qs + 128; float* vs = ks + 128; float* red = vs + 128; float* part = red + 16; float* part2 = part + 512;
    const int tid = opaque_tid(), wave = tid >> 6, lane = tid & 63;
    const int nb = gridDim.x / 2;
    if ((int)blockIdx.x >= nb) return;
    for (int item = blockIdx.x; item < BATCH * NH; item += nb) {
        const int b = item / NH, h = item % NH;
        float S[32];
#pragma unroll
        for (int i = 0; i < 32; ++i) S[i] = 0.f;
        const int dv = tid & 127, grp = tid >> 7;
        const int pid = tid >> 7, c = tid & 127;
        const int ch = (pid < 3 ? pid : 0) * 512 + h * 128 + c;
        float cw[4];
#pragma unroll
        for (int j = 0; j < 4; ++j) cw[j] = P.conv_w[(size_t)(l * 4 + j) * QKV + ch];
        const float ng = P.dn_g[l * 128 + dv];
        for (int t = 0; t < SEQ; ++t) {
            const int row = b * SEQ + t;
            float val = 0.f;
            if (tid < 384) {
                float a = 0.f;
#pragma unroll
                for (int j = 0; j < 4; ++j) { const int tt = t - 3 + j; if (tt >= 0) a += cw[j] * bf2f(P.QKVR[(size_t)(row - 3 + j) * QKV + ch]); }
                val = siluf(a);
                const float ss = wave_sum(val * val);
                if (lane == 0) red[wave] = ss;
            }
            __syncthreads();
            if (tid < 384) {
                if (pid < 2) { const float tot = red[2 * pid] + red[2 * pid + 1]; val *= rsqrtf(tot + EPS); if (pid == 0) val *= 0.08838834764831845f; }
                (pid == 0 ? qs : (pid == 1 ? ks : vs))[c] = val;
            }
            __syncthreads();
            const float g = P.GLOG[(size_t)row * 4 + h], beta = P.BETA[(size_t)row * 4 + h];
            const float eg = __expf(g);
            float pp = 0.f;
#pragma unroll
            for (int i = 0; i < 32; ++i) { S[i] *= eg; pp += ks[grp * 32 + i] * S[i]; }
            part[grp * 128 + dv] = pp;
            __syncthreads();
            const float pred = part[dv] + part[128 + dv] + part[256 + dv] + part[384 + dv];
            const float delta = beta * (vs[dv] - pred);
            float op = 0.f;
#pragma unroll
            for (int i = 0; i < 32; ++i) { S[i] += ks[grp * 32 + i] * delta; op += qs[grp * 32 + i] * S[i]; }
            part2[grp * 128 + dv] = op;
            __syncthreads();
            float o = 0.f;
            if (tid < 128) {
                o = part2[tid] + part2[128 + tid] + part2[256 + tid] + part2[384 + tid];
                const float ss = wave_sum(o * o);
                if (lane == 0) red[8 + wave] = ss;
            }
            __syncthreads();
            if (tid < 128) {
                const float rinv = rsqrtf((red[8] + red[9]) * (1.f / 128.f) + EPS);
                const float z = bf2f(P.ZDN[(size_t)row * 512 + h * 128 + tid]);
                P.MIXIN[(size_t)row * D + h * 128 + tid] = f2bf(o * rinv * ng * z);
            }
        }
        __syncthreads();
    }
}

__device__ __forceinline__ void s5_naive(const Ptrs& P, int l) {
    const int nb = gridDim.x / 2;
    if ((int)blockIdx.x < nb) return;
    const int tid_ = opaque_tid(); const int lane = tid_ & 63, wave = tid_ >> 6;
    const int gw = ((int)blockIdx.x - nb) * NWAVES + wave, ngw = ((int)gridDim.x - nb) * NWAVES;
    for (int item = gw; item < BATCH * NG; item += ngw) {
        const int b = item / NG, g = item % NG, p = lane;
        const float dt = __expf(P.log_dt[l * NG + g]);
        const float are = P.a_re[(size_t)(l * NG + g) * SP + p], aim = P.a_im[(size_t)(l * NG + g) * SP + p];
        const float mag = __expf(are * dt), ang = aim * dt;
        float sn, cs; sincosf(ang, &sn, &cs);
        const float lr = mag * cs, li = mag * sn;
        const float den = are * are + aim * aim, nr = lr - 1.f, ni = li;
        const float cfr = (nr * are + ni * aim) / den, cfi = (ni * are - nr * aim) / den;
        float bbr[16], bbi[16], cr[16], ci[16];
#pragma unroll
        for (int hh = 0; hh < 16; ++hh) {
            const float br = P.b_re[((size_t)(l * NG + g) * SP + p) * 16 + hh], bi = P.b_im[((size_t)(l * NG + g) * SP + p) * 16 + hh];
            bbr[hh] = cfr * br - cfi * bi; bbi[hh] = cfr * bi + cfi * br;
            cr[hh] = P.c_re[((size_t)(l * NG + g) * 16 + hh) * SP + p]; ci[hh] = P.c_im[((size_t)(l * NG + g) * 16 + hh) * SP + p];
        }
        const float dd = lane < 16 ? P.sd[l * SW + g * 16 + lane] : 0.f;
        float xr = 0.f, xi = 0.f;
        for (int t = 0; t < SEQ; ++t) {
            const int row = b * SEQ + t;
            const bf16* up = P.UGX + ((size_t)g * 1024 + b * 32 + (t >> 6)) * UGX_LD + (t & 63) * 16;
            const uint4 u0 = *(const uint4*)up, u1 = *(const uint4*)(up + 8);
            float u[16];
            u[0] = bf2f((bf16)(u0.x & 0xffff)); u[1] = bf2f((bf16)(u0.x >> 16)); u[2] = bf2f((bf16)(u0.y & 0xffff)); u[3] = bf2f((bf16)(u0.y >> 16));
            u[4] = bf2f((bf16)(u0.z & 0xffff)); u[5] = bf2f((bf16)(u0.z >> 16)); u[6] = bf2f((bf16)(u0.w & 0xffff)); u[7] = bf2f((bf16)(u0.w >> 16));
            u[8] = bf2f((bf16)(u1.x & 0xffff)); u[9] = bf2f((bf16)(u1.x >> 16)); u[10] = bf2f((bf16)(u1.y & 0xffff)); u[11] = bf2f((bf16)(u1.y >> 16));
            u[12] = bf2f((bf16)(u1.z & 0xffff)); u[13] = bf2f((bf16)(u1.z >> 16)); u[14] = bf2f((bf16)(u1.w & 0xffff)); u[15] = bf2f((bf16)(u1.w >> 16));
            float bur = 0.f, bui = 0.f;
#pragma unroll
            for (int hh = 0; hh < 16; ++hh) { bur += bbr[hh] * u[hh]; bui += bbi[hh] * u[hh]; }
            const float nxr = lr * xr - li * xi + bur, nxi = lr * xi + li * xr + bui;
            xr = nxr; xi = nxi;
            float my = 0.f, myu = 0.f;
#pragma unroll
            for (int hh = 0; hh < 16; ++hh) {
                const float y = wave_sum(cr[hh] * xr - ci[hh] * xi);
                if (lane == hh) { my = y; myu = u[hh]; }
            }
            if (lane < 16) P.YS[(size_t)row * SW + g * 16 + lane] = f2bf(gelu_tanh(my + dd * myu));
        }
    }
}

#define LAS __attribute__((address_space(3)))
#define GAS __attribute__((address_space(1)))
typedef short bf16x8 __attribute__((ext_vector_type(8)));
typedef float f32x4 __attribute__((ext_vector_type(4)));
typedef unsigned u32x4 __attribute__((ext_vector_type(4)));
namespace pg8 {
constexpr int BM = 256, BK = 64, HALF = 128, HTB = HALF * BK * 2, STAGE_BYTES = 8 * HTB, NXCD = 8, WGM = 8;
__host__ __device__ __forceinline__ int lds_byte(int r, int c) { const int st = (r >> 4) * 2 + (c >> 5), rr = r & 15, cc = c & 31, ob = rr * 64 + cc * 2; return st * 1024 + (ob ^ (((ob >> 9) & 1) << 5)); }
__host__ __device__ __forceinline__ void stage_rc(int b, int& R, int& C) { const int st = b / 1024, sb = b % 1024, swz = sb ^ (((sb >> 9) & 1) << 5); R = (st >> 1) * 16 + swz / 64; C = (st & 1) * 32 + (swz % 64) / 2; }
__host__ __device__ __forceinline__ int perm32(int rho) { const int n = rho >> 4, i = rho & 15; return 8 * (i >> 2) + 4 * n + (i & 3); }
struct Unit { int pm, pn; };
struct Gemm { const bf16* A; const bf16* Bt; int lda, ldb, K, mg; };
struct StaticOrder {
    int nM, nN, nwg, G, c;
    __device__ void init(int M, int N, int G_, int c_) { nM = M / BM; nN = N / BM; nwg = nM * nN; G = G_; c = c_; }
    __device__ bool next(int i, Unit& u) const {
        const long L = (long)i * G + c; if (L >= nwg) return false;
        int wgid = (int)L; { const int q = nwg / NXCD, r = nwg % NXCD, xcd = wgid % NXCD, off = wgid / NXCD; wgid = (xcd < r ? xcd * (q + 1) : r * (q + 1) + (xcd - r) * q) + off; }
        const int nig = WGM * nN, gid = wgid / nig, fm = gid * WGM, gsz = (nM - fm) < WGM ? (nM - fm) : WGM;
        u.pm = fm + ((wgid % nig) % gsz); u.pn = (wgid % nig) / gsz; return true;
    }
};
__device__ __forceinline__ unsigned cvt_pk_bf16(float lo, float hi) { unsigned r; asm volatile("v_cvt_pk_bf16_f32 %0, %1, %2" : "=v"(r) : "v"(lo), "v"(hi)); return r; }

template <class Epi>
__device__ __forceinline__ void gemm_phase(LAS unsigned char* lds, const Gemm g, const StaticOrder& S, const Epi& E) {
    const int tid = opaque_tid(), wid = __builtin_amdgcn_readfirstlane(tid >> 6), lane = tid & 63, wr = wid >> 2, wc = wid & 3, fr = lane & 15, fq = lane >> 4;
    const int K = g.K, nt = K / BK;
    unsigned voffA[2], voffB[2];
#pragma unroll
    for (int i = 0; i < 2; ++i) { int R, C; stage_rc(tid * 16 + i * 8192, R, C); const int Rb = (R & ~31) + perm32(R & 31);
        voffA[i] = (unsigned)(R * g.lda + C) * 2u; voffB[i] = (unsigned)(Rb * g.ldb + C) * 2u; }
    const size_t kstep = (size_t)(BK * 2);
    const size_t hstepA = (size_t)HALF * g.lda * 2, hstepB = (size_t)HALF * g.ldb * 2;
    const size_t tstepA = 2 * hstepA, tstepB = 2 * hstepB;
    const unsigned ldsw = (unsigned)wid * 1024u;
    const int aoff = lds_byte(wr * 64 + fr, fq * 8), boff = lds_byte(wc * 32 + fr, fq * 8);
#define PG8_SA(b, h) (((b) * 2 + (h)) * HTB)
#define PG8_SB(b, h) ((4 + (b) * 2 + (h)) * HTB)
#define PG8_STAGE(bufoff, gbase, voff) do { _Pragma("unroll") for (int _i = 0; _i < 2; ++_i) \
        __builtin_amdgcn_global_load_lds((const unsigned*)((const char*)(gbase) + (voff)[_i]), (LAS unsigned*)(lds + (bufoff) + ldsw + _i * 8192), 16, 0, 0); } while (0)
#define PG8_LDA(dst, b, h) do { _Pragma("unroll") for (int m = 0; m < 4; ++m) _Pragma("unroll") for (int k = 0; k < 2; ++k) dst[m][k] = *(const LAS bf16x8*)(lds + PG8_SA(b, h) + aoff + m * 2048 + k * 1024); } while (0)
#define PG8_LDB(dst, b, h) do { _Pragma("unroll") for (int n = 0; n < 2; ++n) _Pragma("unroll") for (int k = 0; k < 2; ++k) dst[n][k] = *(const LAS bf16x8*)(lds + PG8_SB(b, h) + boff + n * 2048 + k * 1024); } while (0)
#define PG8_MMA(ai, bj, At, Bt) do { __builtin_amdgcn_s_setprio(1); _Pragma("unroll") for (int m = 0; m < 4; ++m) _Pragma("unroll") for (int n = 0; n < 2; ++n) _Pragma("unroll") for (int k = 0; k < 2; ++k) \
        acc[ai][bj][m][n] = __builtin_amdgcn_mfma_f32_16x16x32_bf16(Bt[n][k], At[m][k], acc[ai][bj][m][n], 0, 0, 0); __builtin_amdgcn_s_setprio(0); } while (0)
#define PG8_WAIT_V(n) asm volatile("s_waitcnt vmcnt(" #n ")" ::: "memory")
#define PG8_WAIT_L(n) asm volatile("s_waitcnt lgkmcnt(" #n ")" ::: "memory")
#define PG8_BAR __builtin_amdgcn_s_barrier()
#define PG8_SCHED __builtin_amdgcn_sched_barrier(0)
    Unit cur, nxt; int ui = 0;
    if (!S.next(0, cur)) return;
    f32x4 acc[2][2][4][2];
#pragma unroll
    for (int a = 0; a < 2; ++a)
#pragma unroll
        for (int b = 0; b < 2; ++b)
#pragma unroll
            for (int m = 0; m < 4; ++m)
#pragma unroll
                for (int n = 0; n < 2; ++n) acc[a][b][m][n] = (f32x4){0.f, 0.f, 0.f, 0.f};
    bf16x8 At[4][2], B0[2][2], B1[2][2];
    const char* cA = (const char*)g.A + (size_t)cur.pm * tstepA; const char* cB = (const char*)g.Bt + (size_t)((cur.pm / g.mg) * S.nN + cur.pn) * tstepB;
    PG8_STAGE(PG8_SB(0, 0), cB, voffB); PG8_STAGE(PG8_SB(0, 1), cB + hstepB, voffB); PG8_STAGE(PG8_SA(0, 0), cA, voffA); PG8_STAGE(PG8_SA(0, 1), cA + hstepA, voffA);
    if (wr == 1) PG8_BAR;
    PG8_WAIT_V(2); PG8_BAR;
    PG8_STAGE(PG8_SB(1, 0), cB + kstep, voffB); PG8_STAGE(PG8_SA(1, 0), cA + kstep, voffA); PG8_STAGE(PG8_SB(1, 1), cB + hstepB + kstep, voffB);
    PG8_WAIT_V(6); PG8_BAR;
    for (;;) {
        const bool has_next = S.next(ui + 1, nxt);
        const char* nA = has_next ? (const char*)g.A + (size_t)nxt.pm * tstepA : cA; const char* nB = has_next ? (const char*)g.Bt + (size_t)((nxt.pm / g.mg) * S.nN + nxt.pn) * tstepB : cB;
        for (int t = 0; t < nt; t += 2) {
            const bool last = (t == nt - 2);
            const char* a1 = cA + (size_t)(t + 1) * kstep;
            const char* a2 = last ? nA : cA + (size_t)(t + 2) * kstep; const char* b2 = last ? nB : cB + (size_t)(t + 2) * kstep;
            const char* a3 = a2 + kstep; const char* b3 = b2 + kstep;
            PG8_LDB(B0, 0, 0); PG8_LDB(B1, 0, 1); PG8_SCHED; PG8_LDA(At, 0, 0); PG8_STAGE(PG8_SA(1, 1), a1 + hstepA, voffA);
            PG8_WAIT_V(8); PG8_WAIT_L(0); PG8_BAR; PG8_MMA(0, 0, At, B0); PG8_MMA(0, 1, At, B1); PG8_BAR; PG8_SCHED;
            PG8_LDA(At, 0, 1); PG8_STAGE(PG8_SB(0, 0), b2, voffB); PG8_STAGE(PG8_SB(0, 1), b2 + hstepB, voffB); PG8_STAGE(PG8_SA(0, 0), a2, voffA);
            PG8_WAIT_V(8); PG8_WAIT_L(0); PG8_BAR; PG8_MMA(1, 0, At, B0); PG8_MMA(1, 1, At, B1); PG8_BAR; PG8_SCHED;
            PG8_LDB(B0, 1, 0); PG8_LDB(B1, 1, 1); PG8_SCHED; PG8_LDA(At, 1, 0); PG8_STAGE(PG8_SA(0, 1), a2 + hstepA, voffA);
            PG8_WAIT_V(8); PG8_WAIT_L(0); PG8_BAR; PG8_MMA(0, 0, At, B0); PG8_MMA(0, 1, At, B1); PG8_BAR; PG8_SCHED;
            PG8_LDA(At, 1, 1); PG8_STAGE(PG8_SB(1, 0), b3, voffB); PG8_STAGE(PG8_SB(1, 1), b3 + hstepB, voffB); PG8_STAGE(PG8_SA(1, 0), a3, voffA);
            PG8_WAIT_V(8); PG8_WAIT_L(0); PG8_BAR; PG8_MMA(1, 0, At, B0); PG8_MMA(1, 1, At, B1); PG8_BAR; PG8_SCHED;
        }
        if (wr == 0) PG8_BAR;
        E(acc, cur, wr, wc, fr, fq);
        if (!has_next) break;
#pragma unroll
        for (int a = 0; a < 2; ++a)
#pragma unroll
            for (int b = 0; b < 2; ++b)
#pragma unroll
                for (int m = 0; m < 4; ++m)
#pragma unroll
                    for (int n = 0; n < 2; ++n) acc[a][b][m][n] = (f32x4){0.f, 0.f, 0.f, 0.f};
        cur = nxt; cA = nA; cB = nB; ++ui;
        if (wr == 1) PG8_BAR;
    }
    PG8_WAIT_V(0);
    PG8_BAR;
#undef PG8_SA
#undef PG8_SB
#undef PG8_STAGE
#undef PG8_LDA
#undef PG8_LDB
#undef PG8_MMA
#undef PG8_WAIT_V
#undef PG8_WAIT_L
#undef PG8_BAR
#undef PG8_SCHED
}
}

__device__ __forceinline__ u32x4 pack8(const f32x4 v0, const f32x4 v1) {
    u32x4 w; w.x = pg8::cvt_pk_bf16(v0[0], v0[1]); w.y = pg8::cvt_pk_bf16(v0[2], v0[3]); w.z = pg8::cvt_pk_bf16(v1[0], v1[1]); w.w = pg8::cvt_pk_bf16(v1[2], v1[3]); return w;
}
__device__ __forceinline__ f32x4 silu4(f32x4 v) { f32x4 r; r[0] = siluf(v[0]); r[1] = siluf(v[1]); r[2] = siluf(v[2]); r[3] = siluf(v[3]); return r; }
struct EpiInProj {
    bf16 *QKVR, *ZDN, *ZS, *UGX; float *BETA, *GLOG; const float *a_log, *dt_bias;
    __device__ __forceinline__ void operator()(const f32x4 (&acc)[2][2][4][2], const pg8::Unit& u, int wr, int wc, int fr, int fq) const {
        const int pn = u.pn, row0 = u.pm * 256 + wr * 64 + fr, cw = wc * 32 + 8 * fq;
        if (pn == 12) {
            if (wc == 0 && fq == 0) {
                const f32x4 al = *(const f32x4*)a_log, db = *(const f32x4*)dt_bias;
#pragma unroll
                for (int ai = 0; ai < 2; ++ai)
#pragma unroll
                    for (int m = 0; m < 4; ++m) {
                        const int row = row0 + ai * 128 + m * 16;
                        const f32x4 b = acc[ai][0][m][0], a = acc[ai][0][m][1];
                        f32x4 bo, go;
#pragma unroll
                        for (int j = 0; j < 4; ++j) { bo[j] = sigmf(b[j]); go[j] = -__expf(al[j]) * softplusf(a[j] + db[j]); }
                        *(f32x4*)(BETA + (size_t)row * 4) = bo; *(f32x4*)(GLOG + (size_t)row * 4) = go;
                    }
            }
            return;
        }
#pragma unroll
        for (int ai = 0; ai < 2; ++ai)
#pragma unroll
            for (int m = 0; m < 4; ++m) {
                const int row = row0 + ai * 128 + m * 16;
#pragma unroll
                for (int bj = 0; bj < 2; ++bj) {
                    f32x4 v0 = acc[ai][bj][m][0], v1 = acc[ai][bj][m][1];
                    const int ct = bj * 128 + cw;
                    bf16* dst;
                    if (pn < 6) dst = QKVR + (size_t)row * QKV + pn * 256 + ct;
                    else if (pn < 8) { v0 = silu4(v0); v1 = silu4(v1); dst = ZDN + (size_t)row * 512 + (pn - 6) * 256 + ct; }
                    else if (pn < 10) { const int c = (pn - 8) * 256 + ct; dst = UGX + ((size_t)(c >> 4) * 1024 + (row >> 6)) * UGX_LD + (row & 63) * 16 + (c & 15); }
                    else { v0 = silu4(v0); v1 = silu4(v1); dst = ZS + (size_t)row * 512 + (pn - 10) * 256 + ct; }
                    *(u32x4*)dst = pack8(v0, v1);
                }
            }
    }
};
struct EpiGlu {
    bf16* MIXIN; const bf16* ZS; const float* glu_b;
    __device__ __forceinline__ void operator()(const f32x4 (&acc)[2][2][4][2], const pg8::Unit& u, int wr, int wc, int fr, int fq) const {
        const int row0 = u.pm * 256 + wr * 64 + fr, col = u.pn * 128 + wc * 32 + 8 * fq;
        const f32x4 bv0 = *(const f32x4*)(glu_b + col), bv1 = *(const f32x4*)(glu_b + col + 4), bg0 = *(const f32x4*)(glu_b + 512 + col), bg1 = *(const f32x4*)(glu_b + 512 + col + 4);
#pragma unroll
        for (int ai = 0; ai < 2; ++ai)
#pragma unroll
            for (int m = 0; m < 4; ++m) {
                const int row = row0 + ai * 128 + m * 16;
                const u32x4 z = *(const u32x4*)(ZS + (size_t)row * 512 + col);
                const f32x4 a0 = acc[ai][0][m][0] + bv0, a1 = acc[ai][0][m][1] + bv1, g0 = acc[ai][1][m][0] + bg0, g1 = acc[ai][1][m][1] + bg1;
                f32x4 o0, o1;
                o0[0] = a0[0] * sigmf(g0[0]) * bf2f((bf16)(z.x & 0xffff)); o0[1] = a0[1] * sigmf(g0[1]) * bf2f((bf16)(z.x >> 16));
                o0[2] = a0[2] * sigmf(g0[2]) * bf2f((bf16)(z.y & 0xffff)); o0[3] = a0[3] * sigmf(g0[3]) * bf2f((bf16)(z.y >> 16));
                o1[0] = a1[0] * sigmf(g1[0]) * bf2f((bf16)(z.z & 0xffff)); o1[1] = a1[1] * sigmf(g1[1]) * bf2f((bf16)(z.z >> 16));
                o1[2] = a1[2] * sigmf(g1[2]) * bf2f((bf16)(z.w & 0xffff)); o1[3] = a1[3] * sigmf(g1[3]) * bf2f((bf16)(z.w >> 16));
                *(u32x4*)(MIXIN + (size_t)row * D + 512 + col) = pack8(o0, o1);
            }
    }
};
struct EpiOut {
    bf16* MIXO; float* SSQ;
    __device__ __forceinline__ void operator()(const f32x4 (&acc)[2][2][4][2], const pg8::Unit& u, int wr, int wc, int fr, int fq) const {
        const int row0 = u.pm * 256 + wr * 64 + fr, col0 = u.pn * 256 + wc * 32 + 8 * fq;
#pragma unroll
        for (int ai = 0; ai < 2; ++ai)
#pragma unroll
            for (int m = 0; m < 4; ++m) {
                const int row = row0 + ai * 128 + m * 16;
                float s = 0.f;
#pragma unroll
                for (int bj = 0; bj < 2; ++bj) {
                    const f32x4 v0 = acc[ai][bj][m][0], v1 = acc[ai][bj][m][1];
                    s += (v0[0] * v0[0] + v0[1] * v0[1]) + (v0[2] * v0[2] + v0[3] * v0[3]) + (v1[0] * v1[0] + v1[1] * v1[1]) + (v1[2] * v1[2] + v1[3] * v1[3]);
                    *(u32x4*)(MIXO + (size_t)row * D + col0 + bj * 128) = pack8(v0, v1);
                }
                s += __shfl_xor(s, 16); s += __shfl_xor(s, 32);
                if (fq == 0) SSQ[(size_t)row * 16 + u.pn * 4 + wc] = s;
            }
    }
};

__device__ __forceinline__ unsigned pk2(float lo, float hi) { return (unsigned)f2bf(lo) | ((unsigned)f2bf(hi) << 16); }
template <int KIND> __device__ __forceinline__ int wsrc(int n) {
    if (KIND == 0) return n < 2048 ? n : (n < 3072 ? n + 8 : (n < 3080 ? n - 1024 : -1));
    if (KIND == 1) { const int pn = n >> 8, j = n & 255; return j < 128 ? pn * 128 + j : 512 + pn * 128 + (j - 128); }
    return n;
}
template <int KIND>
__device__ __forceinline__ void transpose_item(const float* W, int K, int N, bf16* WT, LAS float* scr, int item, int nblk, int lane) {
    const int kb = item / nblk, nb = item % nblk, k0 = 64 * kb, n0 = 32 * nb;
    const int sc = wsrc<KIND>(n0 + (lane & 31));
#pragma unroll 8
    for (int i = 0; i < 32; ++i) { const int kk = 2 * i + (lane >> 5); scr[kk * 33 + (lane & 31)] = sc >= 0 ? W[(size_t)(k0 + kk) * N + sc] : 0.f; }
    asm volatile("s_waitcnt lgkmcnt(0)" ::: "memory");
    const int c = lane & 7;
#pragma unroll
    for (int j = 0; j < 4; ++j) { const int n = (lane >> 3) + 8 * j; const LAS float* s = scr + (8 * c) * 33 + n;
        u32x4 o; o.x = pk2(s[0 * 33], s[1 * 33]); o.y = pk2(s[2 * 33], s[3 * 33]); o.z = pk2(s[4 * 33], s[5 * 33]); o.w = pk2(s[6 * 33], s[7 * 33]);
        *(u32x4*)(WT + (size_t)(n0 + n) * K + k0 + 8 * c) = o; }
    asm volatile("s_waitcnt lgkmcnt(0)" ::: "memory");
}
__device__ __forceinline__ void prologue_weights(LAS unsigned char* lds, const Ptrs& P, unsigned char* ws) {
    const int tid_ = opaque_tid(); const int lane = tid_ & 63, wave = __builtin_amdgcn_readfirstlane(tid_ >> 6);
    LAS float* scr = (LAS float*)(lds + wave * 16384);
    const int gw = blockIdx.x * NWAVES + wave, ngw = gridDim.x * NWAVES;
    constexpr int I_IN = (D / 64) * (3328 / 32), I_GLU = (SW / 64) * (1024 / 32), I_OUT = (D / 64) * (D / 32);
    constexpr int PER = I_IN + I_GLU + I_OUT;
    for (int it = gw; it < DEPTH * PER; it += ngw) {
        const int l = it / PER; int r = it % PER;
        if (r < I_IN) { transpose_item<0>(P.w_in + (size_t)l * D * INC, D, INC, (bf16*)(ws + WS_WIN) + (size_t)l * 3328 * D, scr, r, 3328 / 32, lane); continue; } r -= I_IN;
        if (r < I_GLU) { transpose_item<1>(P.glu_w + (size_t)l * SW * 1024, SW, 1024, (bf16*)(ws + WS_WGLU) + (size_t)l * 1024 * SW, scr, r, 1024 / 32, lane); continue; } r -= I_GLU;
        transpose_item<2>(P.w_out + (size_t)l * D * D, D, D, (bf16*)(ws + WS_WOUT) + (size_t)l * D * D, scr, r, D / 32, lane);
    }
}

__global__ void __launch_bounds__(NTHREADS, 2) fwd(Args a) {
    extern __shared__ __attribute__((aligned(16))) unsigned char lds[];
    cg::grid_group grid = cg::this_grid();
    Ptrs P;
    P.x = a.in[0]; P.pre_g = a.in[1]; P.post_g = a.in[2]; P.w_in = a.in[3]; P.conv_w = a.in[4]; P.a_log = a.in[5]; P.dt_bias = a.in[6]; P.dn_g = a.in[7];
    P.a_re = a.in[8]; P.a_im = a.in[9]; P.b_re = a.in[10]; P.b_im = a.in[11]; P.c_re = a.in[12]; P.c_im = a.in[13]; P.sd = a.in[14]; P.log_dt = a.in[15];
    P.glu_w = a.in[16]; P.glu_b = a.in[17]; P.w_out = a.in[18]; P.out = a.out;
    unsigned char* ws = a.ws;
    P.XN = (bf16*)(ws + WS_XN); P.MIXIN = P.XN; P.QKVR = (bf16*)(ws + WS_QKV); P.MIXO = (bf16*)(ws + WS_MIXO); P.YS = (bf16*)(ws + WS_YS);
    P.ZDN = (bf16*)(ws + WS_ZDN); P.ZS = (bf16*)(ws + WS_ZS); P.UGX = (bf16*)(ws + WS_UGX);
    P.BETA = (float*)(ws + WS_BETA); P.GLOG = (float*)(ws + WS_GLOG); P.SSQ = (float*)(ws + WS_SSQ);
#define IN(k) (a.lo <= (k) && (k) < a.hi)
#define SEAM(k) do { if (IN(k) && IN((k) + 1)) grid.sync(); } while (0)
#pragma unroll
    for (int l = 0; l < DEPTH; ++l) {
        if (IN(5 * l + 0)) {
            if (l == 0) { prologue_weights((LAS unsigned char*)lds, P, ws); p0_norm(P, 0, P.x, nullptr, nullptr, P.pre_g); }
            else p0_norm(P, 1, l == 1 ? P.x : P.out, P.out, P.post_g + (l - 1) * D, P.pre_g + l * D);
        }
        SEAM(5 * l + 0);
        if (IN(5 * l + 1)) {
#if FAST_P1
            pg8::Gemm g{P.XN, (const bf16*)(ws + WS_WIN) + (size_t)l * 3328 * D, D, D, D, 1 << 20};
            pg8::StaticOrder S; S.init(T, 3328, gridDim.x, blockIdx.x);
            EpiInProj E{P.QKVR, P.ZDN, P.ZS, P.UGX, P.BETA, P.GLOG, P.a_log + l * 4, P.dt_bias + l * 4};
            pg8::gemm_phase<EpiInProj>((LAS unsigned char*)lds, g, S, E);
#else
            ngemm<0>(lds, P, l, P.XN, D, P.w_in + (size_t)l * D * INC, INC, INC, D);
#endif
        }
        SEAM(5 * l + 1);
        if (IN(5 * l + 2)) {
            dn_naive(lds, P, l);
            s5_naive(P, l);
        }
        SEAM(5 * l + 2);
        if (IN(5 * l + 3)) {
#if FAST_P3
            pg8::Gemm g{P.YS, (const bf16*)(ws + WS_WGLU) + (size_t)l * 1024 * SW, SW, SW, SW, 1 << 20};
            pg8::StaticOrder S; S.init(T, 1024, gridDim.x, blockIdx.x);
            EpiGlu E{P.MIXIN, P.ZS, P.glu_b + l * 1024};
            pg8::gemm_phase<EpiGlu>((LAS unsigned char*)lds, g, S, E);
#else
            ngemm<1>(lds, P, l, P.YS, SW, P.glu_w + (size_t)l * SW * 1024, 1024, 512, SW);
#endif
        }
        SEAM(5 * l + 3);
        if (IN(5 * l + 4)) {
#if FAST_P4
            pg8::Gemm g{P.MIXIN, (const bf16*)(ws + WS_WOUT) + (size_t)l * D * D, D, D, D, 1 << 20};
            pg8::StaticOrder S; S.init(T, D, gridDim.x, blockIdx.x);
            EpiOut E{P.MIXO, P.SSQ};
            pg8::gemm_phase<EpiOut>((LAS unsigned char*)lds, g, S, E);
#else
            ngemm<2>(lds, P, l, P.MIXIN, D, P.w_out + (size_t)l * D * D, D, D, D);
#endif
        }
        SEAM(5 * l + 4);
    }
    if (IN(5 * DEPTH)) p0_norm(P, 2, P.out, P.out, P.post_g + (DEPTH - 1) * D, nullptr);
#undef IN
#undef SEAM
}

extern "C" void kernel_launch(void* const* d_in, const int* in_sizes, int n_in, void* d_out, int out_size, void* d_ws, size_t ws_size, hipStream_t stream) {
    static int grid = 0;
    if (grid == 0) {
        if (n_in != 19 || in_sizes[0] != T * D || out_size != T * D || ws_size < WS_END) {
            fprintf(stderr, "kernel_launch: unexpected shapes/workspace: n_in %d in0 %d out %d ws %zu (need %zu)\n", n_in, n_in > 0 ? in_sizes[0] : -1, out_size, ws_size, (size_t)WS_END);
            grid = -1; return;
        }
        int dev = 0, cus = 0, per_cu = 0;
        hipGetDevice(&dev);
        hipDeviceGetAttribute(&cus, hipDeviceAttributeMultiprocessorCount, dev);
        hipFuncSetAttribute((const void*)fwd, hipFuncAttributeMaxDynamicSharedMemorySize, LDS_BYTES);
        hipOccupancyMaxActiveBlocksPerMultiprocessor(&per_cu, (const void*)fwd, NTHREADS, LDS_BYTES);
        if (per_cu < 1) { fprintf(stderr, "kernel_launch: occupancy query says %d blocks/CU\n", per_cu); per_cu = 1; }
        (void)hipGetLastError();
        grid = cus;
        fprintf(stderr, "kernel_launch: cus %d per_cu %d grid %d ws %zu\n", cus, per_cu, grid, ws_size);
    }
    if (grid < 0) return;
    Args a{};
    for (int i = 0; i < 19; ++i) a.in[i] = (const float*)d_in[i];
    a.out = (float*)d_out; a.ws = (unsigned char*)d_ws; a.lo = 0; a.hi = 5 * DEPTH + 1;
    void* args[] = {&a};
    hipError_t e = hipLaunchCooperativeKernel((const void*)fwd, dim3(grid), dim3(NTHREADS), args, LDS_BYTES, stream);
    if (e != hipSuccess) fprintf(stderr, "cooperative launch failed: %s (grid %d)\n", hipGetErrorString(e), grid);
}
```

```cpp
#include <hip/hip_runtime.h>
#include <hip/hip_cooperative_groups.h>
#include <cstdio>
#include <cstdint>
namespace cg = cooperative_groups;
#ifndef PROBE_REP
#define PROBE_REP -1
#endif
#ifndef FAST_P1
#define FAST_P1 1
#endif
#ifndef FAST_P3
#define FAST_P3 1
#endif
#ifndef FAST_P4
#define FAST_P4 1
#endif
#ifndef FAST_S5
#define FAST_S5 1
#endif
#ifndef FAST_DN
#define FAST_DN 1
#endif

constexpr int D = 1024, BATCH = 32, SEQ = 2048, DEPTH = 2, T = BATCH * SEQ;
constexpr int NH = 4, HD = 128, DNW = 512, QKV = 1536;
constexpr int NG = 32, SGC = 16, SP = 64, SW = 512;
constexpr int INC = 3080;
constexpr int C_ZDN = 1536, C_BETA = 2048, C_ALPHA = 2052, C_U = 2056, C_ZS = 2568;
constexpr float EPS = 1e-6f;
constexpr int NTHREADS = 512, NWAVES = 8;
constexpr int LDS_BYTES = 155648;
constexpr int NPH = 6;
constexpr int MISC_OFF = 153600;
constexpr size_t CTL_ZERO_BYTES = 65536;

typedef unsigned short bf16;
typedef float f32x4 __attribute__((ext_vector_type(4)));
typedef float f32x2 __attribute__((ext_vector_type(2)));
#define LAS __attribute__((address_space(3)))
__device__ __forceinline__ float bf2f(bf16 v) { return __uint_as_float(((unsigned)v) << 16); }
typedef __bf16 bf16x2_t __attribute__((ext_vector_type(2)));
__device__ __forceinline__ unsigned cvtpk(float lo, float hi) { bf16x2_t v; v[0] = (__bf16)lo; v[1] = (__bf16)hi; return __builtin_bit_cast(unsigned, v); }
__device__ __forceinline__ bf16 f2bf(float f) { return (bf16)(cvtpk(f, 0.f) & 0xffffu); }
__device__ __forceinline__ float siluf(float x) { return x * __builtin_amdgcn_rcpf(1.f + __expf(-x)); }
__device__ __forceinline__ float sigmf(float x) { return __builtin_amdgcn_rcpf(1.f + __expf(-x)); }
__device__ __forceinline__ float softplusf(float x) { return fmaxf(x, 0.f) + __logf(1.f + __expf(-fabsf(x))); }
__device__ __forceinline__ float gelu_tanh(float x) { const float u = 0.7978845608028654f * (x + 0.044715f * x * x * x); return 0.5f * x * (1.f + tanhf(u)); }
__device__ __forceinline__ int opaque_bid() { int t = blockIdx.x; asm volatile("" : "+s"(t)); return t; }
__device__ __forceinline__ int opaque_grid() { int t = gridDim.x; asm volatile("" : "+s"(t)); return t; }
__device__ __forceinline__ int opaque_tid() { int t = threadIdx.x; asm volatile("" : "+v"(t)); return t; }
#define DPPF(old_, v_, ctrl_, rmask_) __int_as_float(__builtin_amdgcn_update_dpp(__float_as_int(old_), __float_as_int(v_), (ctrl_), (rmask_), 0xF, false))
__device__ __forceinline__ float sum8_dpp(float v) {
    v += DPPF(0.f, v, 0xB1, 0xF); v += DPPF(0.f, v, 0x4E, 0xF); v += DPPF(0.f, v, 0x141, 0xF);
    return v;
}
__device__ __forceinline__ float wave_sum(float v) {
    v = sum8_dpp(v);
    v += DPPF(0.f, v, 0x140, 0xF);
    v += DPPF(0.f, v, 0x142, 0xA);
    v += DPPF(0.f, v, 0x143, 0xC);
    return __int_as_float(__builtin_amdgcn_readlane(__float_as_int(v), 63));
}
__device__ __forceinline__ float wave_scan_incl(float v) {
    v += DPPF(0.f, v, 0x111, 0xF); v += DPPF(0.f, v, 0x112, 0xF); v += DPPF(0.f, v, 0x114, 0xF); v += DPPF(0.f, v, 0x118, 0xF);
    v += DPPF(0.f, v, 0x142, 0xA); v += DPPF(0.f, v, 0x143, 0xC);
    return v;
}

constexpr size_t MiB = 1u << 20;
constexpr size_t WS_CTL = 0;
constexpr size_t WS_WIN = 2 * MiB, WS_WGLU = 16 * MiB, WS_WOUT = 18 * MiB;
constexpr size_t WS_BETA = 22 * MiB, WS_GLOG = 23 * MiB, WS_SSQ = 24 * MiB;
constexpr size_t WS_XN = 32 * MiB;
constexpr size_t WS_QKV = 160 * MiB;
constexpr size_t WS_KTAB = 29 * MiB;
constexpr size_t WS_EST = 552 * MiB, WS_TF = 568 * MiB, WS_WE = 640 * MiB;
constexpr size_t WS_DNUT = 720 * MiB, WS_DNW = 784 * MiB, WS_DNQG = 848 * MiB, WS_DNKD = 912 * MiB, WS_DNIN = 976 * MiB, WS_GLAST = 28 * MiB;
constexpr size_t WS_MIXO = 160 * MiB, WS_YS = 656 * MiB;
constexpr size_t WS_ZDN = 352 * MiB, WS_ZS = 416 * MiB;
constexpr size_t WS_UGX = 480 * MiB;
constexpr size_t WS_END = 1008 * MiB;
constexpr int UGX_LD = 1152;

struct Args { const float* in[19]; float* out; unsigned char* ws; int lo, hi; };

struct Ptrs {
    const float *x, *pre_g, *post_g, *w_in, *conv_w, *a_log, *dt_bias, *dn_g, *a_re, *a_im, *b_re, *b_im, *c_re, *c_im, *sd, *log_dt, *glu_w, *glu_b, *w_out;
    float* out;
    bf16 *XN, *MIXIN, *QKVR, *MIXO, *YS, *ZDN, *ZS, *UGX;
    float *BETA, *GLOG, *SSQ;
};

__device__ __forceinline__ void p0_norm(LAS unsigned char* lds, const Ptrs& P, int l, int mode, const float* xsrc, float* xdst, const float* postg, const float* preg) {
    const int BID = opaque_bid(), GRD = opaque_grid(); (void)BID; (void)GRD;
    const int tid_ = opaque_tid(); const int lane = tid_ & 63, wave = tid_ >> 6;
    const int gw = BID * NWAVES + wave, ngw = GRD * NWAVES;
    LAS float* W8 = (LAS float*)lds;
    float alv = 0.f, dbv = 0.f;
    const int cidx = lane >> 3;
    if (mode != 2) {
        __syncthreads();
        for (int e = tid_; e < 8 * 1024; e += NTHREADS) { const int k = e >> 3, c = e & 7; W8[c * 1024 + k] = P.w_in[(size_t)l * D * INC + (size_t)k * INC + C_BETA + c]; }
        __syncthreads();
        if (cidx >= 4) { alv = P.a_log[l * 4 + cidx - 4]; dbv = P.dt_bias[l * 4 + cidx - 4]; }
    }
    struct RowSet { float4 x[4]; uint2 mx[4]; float ss; };
    RowSet SA, SB;
#define P0_LDX(row_, j_, dst_) do { if (mode == 2) { const uint2 t_ = ((const uint2*)(xsrc + (size_t)(row_) * D))[lane + 64 * (j_)]; \
        dst_ = make_float4(__uint_as_float(t_.x), __uint_as_float(t_.y), 0.f, 0.f); } \
        else { const f32x4 t4_ = __builtin_nontemporal_load((const f32x4*)(xsrc + (size_t)(row_) * D) + lane + 64 * (j_)); dst_ = make_float4(t4_[0], t4_[1], t4_[2], t4_[3]); } } while (0)
    LAS float* const Gpo = (LAS float*)lds + 8 * 1024; LAS float* const Gpr = Gpo + 1024;
    { if (mode == 2) __syncthreads();
      for (int e = tid_; e < 1024; e += NTHREADS) { Gpo[e] = mode != 0 ? postg[e] : 0.f; Gpr[e] = mode != 2 ? preg[e] : 0.f; }
      __syncthreads(); }
    auto row_load = [&](RowSet& S, const int r) __attribute__((always_inline)) {
#pragma unroll
        for (int j = 0; j < 4; ++j) P0_LDX(r, j, S.x[j]);
        if (mode != 0) {
            S.ss = P.SSQ[(size_t)r * 16 + (lane & 15)];
            const uint2* mr = (const uint2*)(P.MIXO + (size_t)r * D) + lane;
#pragma unroll
            for (int j = 0; j < 4; ++j) { const unsigned long long t8_ = __builtin_nontemporal_load((const unsigned long long*)(mr + 64 * j)); S.mx[j] = make_uint2((unsigned)t8_, (unsigned)(t8_ >> 32)); }
        } else { S.ss = 0.f;
#pragma unroll
            for (int j = 0; j < 4; ++j) S.mx[j] = make_uint2(0u, 0u); }
    };
    auto row_step = [&](RowSet& S, const int m, const int mnext) __attribute__((always_inline)) {
        float4 v[4]; uint2 mw[4]; float ss = S.ss;
#pragma unroll
        for (int j = 0; j < 4; ++j) { mw[j] = S.mx[j];
            if (mode == 2) { const unsigned a_ = __float_as_uint(S.x[j].x), b_ = __float_as_uint(S.x[j].y);
                v[j] = make_float4(bf2f((bf16)(a_ & 0xffff)), bf2f((bf16)(a_ >> 16)), bf2f((bf16)(b_ & 0xffff)), bf2f((bf16)(b_ >> 16))); }
            else v[j] = S.x[j]; }
        unsigned lb_ = 4u * (unsigned)lane; asm volatile("" : "+v"(lb_));
        LAS float* const Wl = (LAS float*)lds + lb_;
        if (mode != 0) {
            ss = wave_sum(lane < 16 ? ss : 0.f);
            f32x2 rq; rq[0] = __builtin_amdgcn_rsqf(ss * (1.f / D) + EPS); rq[1] = rq[0]; asm volatile("" : "+v"(rq));
#pragma unroll
            for (int j = 0; j < 4; ++j) {
                const uint2 w = mw[j];
                const f32x4 g4_ = *(const LAS f32x4*)(Wl + 8 * 1024 + 256 * j); const float4 g = make_float4(g4_[0], g4_[1], g4_[2], g4_[3]);
                v[j].x += bf2f((bf16)(w.x & 0xffff)) * rq[0] * g.x; v[j].y += bf2f((bf16)(w.x >> 16)) * rq[1] * g.y;
                v[j].z += bf2f((bf16)(w.y & 0xffff)) * rq[0] * g.z; v[j].w += bf2f((bf16)(w.y >> 16)) * rq[1] * g.w;
            }
            if (mode == 2) {
                f32x4* xo = (f32x4*)(xdst + (size_t)m * D) + lane;
#pragma unroll
                for (int j = 0; j < 4; ++j) __builtin_nontemporal_store((f32x4){v[j].x, v[j].y, v[j].z, v[j].w}, xo + 64 * j);
            } else {
                uint2* xo = (uint2*)(xdst + (size_t)m * D) + lane;
#pragma unroll
                for (int j = 0; j < 4; ++j) { uint2 w; w.x = cvtpk(v[j].x, v[j].y); w.y = cvtpk(v[j].z, v[j].w); __builtin_nontemporal_store((unsigned long long)w.x | ((unsigned long long)w.y << 32), (unsigned long long*)(xo + 64 * j));
                    v[j] = make_float4(bf2f((bf16)(w.x & 0xffff)), bf2f((bf16)(w.x >> 16)), bf2f((bf16)(w.y & 0xffff)), bf2f((bf16)(w.y >> 16))); }
            }
        }
        if (mode != 2) {
            float s = 0.f;
#pragma unroll
            for (int j = 0; j < 4; ++j) s += v[j].x * v[j].x + v[j].y * v[j].y + v[j].z * v[j].z + v[j].w * v[j].w;
            s = wave_sum(s);
            f32x2 rp; rp[0] = __builtin_amdgcn_rsqf(s * (1.f / D) + EPS); rp[1] = rp[0]; asm volatile("" : "+v"(rp));
            uint2* xo = (uint2*)(P.XN + (size_t)m * D) + lane;
            float dot[8];
#pragma unroll
            for (int c = 0; c < 8; ++c) dot[c] = 0.f;
#pragma unroll
            for (int j = 0; j < 4; ++j) {
                const f32x4 g4_ = *(const LAS f32x4*)(Wl + 9 * 1024 + 256 * j); const float4 g = make_float4(g4_[0], g4_[1], g4_[2], g4_[3]);
                const float h0 = v[j].x * rp[0] * g.x, h1 = v[j].y * rp[1] * g.y, h2 = v[j].z * rp[0] * g.z, h3 = v[j].w * rp[1] * g.w;
                uint2 w;
                w.x = cvtpk(h0, h1); w.y = cvtpk(h2, h3);
                xo[64 * j] = w;
#pragma unroll
                for (int c = 0; c < 8; ++c) { const f32x4 wv = *(const LAS f32x4*)(Wl + c * 1024 + 256 * j); dot[c] += h0 * wv[0] + h1 * wv[1] + h2 * wv[2] + h3 * wv[3]; }
            }
            float r4[4], r2[2], r1;
            {
                const bool hi = (lane & 32) != 0;
#pragma unroll
                for (int c = 0; c < 4; ++c) { const float keep = hi ? dot[c + 4] : dot[c], send = hi ? dot[c] : dot[c + 4]; r4[c] = keep + __shfl_xor(send, 32); }
            }
            {
                const bool hi = (lane & 16) != 0;
#pragma unroll
                for (int c = 0; c < 2; ++c) { const float keep = hi ? r4[c + 2] : r4[c], send = hi ? r4[c] : r4[c + 2]; r2[c] = keep + __shfl_xor(send, 16); }
            }
            {
                const bool hi = (lane & 8) != 0;
                const float keep = hi ? r2[1] : r2[0], send = hi ? r2[0] : r2[1]; r1 = keep + __shfl_xor(send, 8);
            }
            r1 = sum8_dpp(r1);
            {
                float* const dst = cidx < 4 ? P.BETA + (size_t)m * 4 + cidx : P.GLOG + (size_t)m * 4 + (cidx - 4);
                *dst = cidx < 4 ? sigmf(r1) : -__expf(alv) * softplusf(r1 + dbv);
            }
        }
        __builtin_amdgcn_sched_barrier(0);
        row_load(S, mnext < T ? mnext : m);
        __builtin_amdgcn_sched_barrier(0);
    };
    if (gw < T) {
        row_load(SA, gw); row_load(SB, gw + ngw < T ? gw + ngw : gw);
        int m = gw;
        if (m + ngw < T) {
            row_step(SA, m, m + 2 * ngw); row_step(SB, m + ngw, m + 3 * ngw); m += 2 * ngw;
            for (; m + ngw < T; m += 2 * ngw) { row_step(SA, m, m + 2 * ngw); row_step(SB, m + ngw, m + 3 * ngw); }
        }
        if (m < T) row_step(SA, m, m);
    }
#undef P0_LDX
}

template <int MODE>
__device__ __forceinline__ void ngemm(unsigned char* ldsb, const Ptrs& P, int l, const bf16* A, int lda, const float* W, int N, int Ncols, int K) {
    const int BID = opaque_bid(), GRD = opaque_grid(); (void)BID; (void)GRD;
    float* As = (float*)ldsb;
    float* Bs = As + 128 * 36;
    float* Bs2 = Bs + 32 * 64;
    const int tid = opaque_tid(), tx = tid & 63, ty = tid >> 6, lane = tid & 63;
    const int nct = (Ncols + 63) / 64, nrt = T / 128;
    for (int tile = BID; tile < nrt * nct; tile += GRD) {
        const int rt = tile / nct, ct = tile % nct;
        const int row0 = rt * 128, col0 = ct * 64;
        float acc[16], acc2[16];
#pragma unroll
        for (int r = 0; r < 16; ++r) { acc[r] = 0.f; acc2[r] = 0.f; }
        for (int k0 = 0; k0 < K; k0 += 32) {
            {
                const int r = tid >> 2, kq = (tid & 3) * 8;
                const uint4 v = *(const uint4*)(A + (size_t)(row0 + r) * lda + k0 + kq);
                float* d = As + r * 36 + kq;
                d[0] = bf2f((bf16)(v.x & 0xffff)); d[1] = bf2f((bf16)(v.x >> 16));
                d[2] = bf2f((bf16)(v.y & 0xffff)); d[3] = bf2f((bf16)(v.y >> 16));
                d[4] = bf2f((bf16)(v.z & 0xffff)); d[5] = bf2f((bf16)(v.z >> 16));
                d[6] = bf2f((bf16)(v.w & 0xffff)); d[7] = bf2f((bf16)(v.w >> 16));
            }
            {
                const int k = tid >> 4, c4 = (tid & 15) * 4;
#pragma unroll
                for (int j = 0; j < 4; ++j) {
                    const int col = col0 + c4 + j;
                    Bs[k * 64 + c4 + j] = col < Ncols ? W[(size_t)(k0 + k) * N + col] : 0.f;
                    if (MODE == 1) Bs2[k * 64 + c4 + j] = W[(size_t)(k0 + k) * N + col + 512];
                }
            }
            __syncthreads();
#pragma unroll 1
            for (int kk = 0; kk < 32; kk += 4) {
                const float b0 = Bs[(kk + 0) * 64 + tx], b1 = Bs[(kk + 1) * 64 + tx], b2 = Bs[(kk + 2) * 64 + tx], b3 = Bs[(kk + 3) * 64 + tx];
                float c0 = 0.f, c1 = 0.f, c2 = 0.f, c3 = 0.f;
                if (MODE == 1) { c0 = Bs2[(kk + 0) * 64 + tx]; c1 = Bs2[(kk + 1) * 64 + tx]; c2 = Bs2[(kk + 2) * 64 + tx]; c3 = Bs2[(kk + 3) * 64 + tx]; }
#pragma unroll
                for (int r = 0; r < 16; ++r) {
                    const float4 a4 = *(const float4*)(As + (ty * 16 + r) * 36 + kk);
                    acc[r] += a4.x * b0 + a4.y * b1 + a4.z * b2 + a4.w * b3;
                    if (MODE == 1) acc2[r] += a4.x * c0 + a4.y * c1 + a4.z * c2 + a4.w * c3;
                }
            }
            __syncthreads();
        }
        const int col = col0 + tx;
#pragma unroll
        for (int r = 0; r < 16; ++r) {
            const int row = row0 + ty * 16 + r;
            const float v = acc[r];
            if (MODE == 0) {
                if (col < Ncols) {
                    if (col < C_ZDN) P.QKVR[(size_t)row * QKV + col] = f2bf(v);
                    else if (col < C_BETA) P.ZDN[(size_t)row * 512 + (col - C_ZDN)] = f2bf(siluf(v));
                    else if (col < C_ALPHA) P.BETA[(size_t)row * 4 + (col - C_BETA)] = sigmf(v);
                    else if (col < C_U) { const int h = col - C_ALPHA; P.GLOG[(size_t)row * 4 + h] = -__expf(P.a_log[l * 4 + h]) * softplusf(v + P.dt_bias[l * 4 + h]); }
                    else if (col < C_ZS) { const int c = col - C_U, g = c >> 4, hh = c & 15, b = row >> 11, t = row & 2047;
                        P.UGX[((size_t)g * 1024 + b * 32 + (t >> 6)) * UGX_LD + (t & 63) * 16 + hh] = f2bf(v); }
                    else P.ZS[(size_t)row * 512 + (col - C_ZS)] = f2bf(siluf(v));
                }
            } else if (MODE == 1) {
                const float val = v + P.glu_b[l * 1024 + col], gate = acc2[r] + P.glu_b[l * 1024 + 512 + col];
                const float o = val * sigmf(gate) * bf2f(P.ZS[(size_t)row * 512 + col]);
                P.MIXIN[(size_t)row * D + 512 + col] = f2bf(o);
            } else {
                P.MIXO[(size_t)row * D + col] = f2bf(v);
                const float s = wave_sum(v * v);
                if (lane == 0) P.SSQ[(size_t)row * 16 + ct] = s;
            }
        }
    }
}

__device__ __forceinline__ void dn_naive(unsigned char* ldsb, const Ptrs& P, int l) {
    const int BID = opaque_bid(), GRD = opaque_grid(); (void)BID; (void)GRD;
    float* qs = (float*)ldsb; float* ks = qs + 128; float* vs = ks + 128; float* red = vs + 128; float* part = red + 16; float* part2 = part + 512;
    const int tid = opaque_tid(), wave = tid >> 6, lane = tid & 63;
    const int nb = GRD / 2;
    if (BID >= nb) return;
    for (int item = BID; item < BATCH * NH; item += nb) {
        const int b = item / NH, h = item % NH;
        float S[32];
#pragma unroll
        for (int i = 0; i < 32; ++i) S[i] = 0.f;
        const int dv = tid & 127, grp = tid >> 7;
        const int pid = tid >> 7, c = tid & 127;
        const int ch = (pid < 3 ? pid : 0) * 512 + h * 128 + c;
        float cw[4];
#pragma unroll
        for (int j = 0; j < 4; ++j) cw[j] = P.conv_w[(size_t)(l * 4 + j) * QKV + ch];
        const float ng = P.dn_g[l * 128 + dv];
        for (int t = 0; t < SEQ; ++t) {
            const int row = b * SEQ + t;
            float val = 0.f;
            if (tid < 384) {
                float a = 0.f;
#pragma unroll
                for (int j = 0; j < 4; ++j) { const int tt = t - 3 + j; if (tt >= 0) a += cw[j] * bf2f(P.QKVR[(size_t)(row - 3 + j) * QKV + ch]); }
                val = siluf(a);
                const float ss = wave_sum(val * val);
                if (lane == 0) red[wave] = ss;
            }
            __syncthreads();
            if (tid < 384) {
                if (pid < 2) { const float tot = red[2 * pid] + red[2 * pid + 1]; val *= __builtin_amdgcn_rsqf(tot + EPS); if (pid == 0) val *= 0.08838834764831845f; }
                (pid == 0 ? qs : (pid == 1 ? ks : vs))[c] = val;
            }
            __syncthreads();
            const float g = P.GLOG[(size_t)row * 4 + h], beta = P.BETA[(size_t)row * 4 + h];
            const float eg = __expf(g);
            float pp = 0.f;
#pragma unroll
            for (int i = 0; i < 32; ++i) { S[i] *= eg; pp += ks[grp * 32 + i] * S[i]; }
            part[grp * 128 + dv] = pp;
            __syncthreads();
            const float pred = part[dv] + part[128 + dv] + part[256 + dv] + part[384 + dv];
            const float delta = beta * (vs[dv] - pred);
            float op = 0.f;
#pragma unroll
            for (int i = 0; i < 32; ++i) { S[i] += ks[grp * 32 + i] * delta; op += qs[grp * 32 + i] * S[i]; }
            part2[grp * 128 + dv] = op;
            __syncthreads();
            float o = 0.f;
            if (tid < 128) {
                o = part2[tid] + part2[128 + tid] + part2[256 + tid] + part2[384 + tid];
                const float ss = wave_sum(o * o);
                if (lane == 0) red[8 + wave] = ss;
            }
            __syncthreads();
            if (tid < 128) {
                const float rinv = __builtin_amdgcn_rsqf((red[8] + red[9]) * (1.f / 128.f) + EPS);
                const float z = bf2f(P.ZDN[(size_t)row * 512 + h * 128 + tid]);
                P.MIXIN[(size_t)row * D + h * 128 + tid] = f2bf(o * rinv * ng * z);
            }
        }
        __syncthreads();
    }
}

__device__ __forceinline__ void s5_naive(const Ptrs& P, int l) {
    const int BID = opaque_bid(), GRD = opaque_grid(); (void)BID; (void)GRD;
    const int nb = GRD / 2;
    if (BID < nb) return;
    const int tid_ = opaque_tid(); const int lane = tid_ & 63, wave = tid_ >> 6;
    const int gw = (BID - nb) * NWAVES + wave, ngw = (GRD - nb) * NWAVES;
    for (int item = gw; item < BATCH * NG; item += ngw) {
        const int b = item / NG, g = item % NG, p = lane;
        const float dt = __expf(P.log_dt[l * NG + g]);
        const float are = P.a_re[(size_t)(l * NG + g) * SP + p], aim = P.a_im[(size_t)(l * NG + g) * SP + p];
        const float mag = __expf(are * dt), ang = aim * dt;
        float sn, cs; sincosf(ang, &sn, &cs);
        const float lr = mag * cs, li = mag * sn;
        const float den = are * are + aim * aim, nr = lr - 1.f, ni = li;
        const float cfr = (nr * are + ni * aim) / den, cfi = (ni * are - nr * aim) / den;
        float bbr[16], bbi[16], cr[16], ci[16];
#pragma unroll
        for (int hh = 0; hh < 16; ++hh) {
            const float br = P.b_re[((size_t)(l * NG + g) * SP + p) * 16 + hh], bi = P.b_im[((size_t)(l * NG + g) * SP + p) * 16 + hh];
            bbr[hh] = cfr * br - cfi * bi; bbi[hh] = cfr * bi + cfi * br;
            cr[hh] = P.c_re[((size_t)(l * NG + g) * 16 + hh) * SP + p]; ci[hh] = P.c_im[((size_t)(l * NG + g) * 16 + hh) * SP + p];
        }
        const float dd = lane < 16 ? P.sd[l * SW + g * 16 + lane] : 0.f;
        float xr = 0.f, xi = 0.f;
        for (int t = 0; t < SEQ; ++t) {
            const int row = b * SEQ + t;
            const bf16* up = P.UGX + ((size_t)g * 1024 + b * 32 + (t >> 6)) * UGX_LD + (t & 63) * 16;
            const uint4 u0 = *(const uint4*)up, u1 = *(const uint4*)(up + 8);
            float u[16];
            u[0] = bf2f((bf16)(u0.x & 0xffff)); u[1] = bf2f((bf16)(u0.x >> 16)); u[2] = bf2f((bf16)(u0.y & 0xffff)); u[3] = bf2f((bf16)(u0.y >> 16));
            u[4] = bf2f((bf16)(u0.z & 0xffff)); u[5] = bf2f((bf16)(u0.z >> 16)); u[6] = bf2f((bf16)(u0.w & 0xffff)); u[7] = bf2f((bf16)(u0.w >> 16));
            u[8] = bf2f((bf16)(u1.x & 0xffff)); u[9] = bf2f((bf16)(u1.x >> 16)); u[10] = bf2f((bf16)(u1.y & 0xffff)); u[11] = bf2f((bf16)(u1.y >> 16));
            u[12] = bf2f((bf16)(u1.z & 0xffff)); u[13] = bf2f((bf16)(u1.z >> 16)); u[14] = bf2f((bf16)(u1.w & 0xffff)); u[15] = bf2f((bf16)(u1.w >> 16));
            float bur = 0.f, bui = 0.f;
#pragma unroll
            for (int hh = 0; hh < 16; ++hh) { bur += bbr[hh] * u[hh]; bui += bbi[hh] * u[hh]; }
            const float nxr = lr * xr - li * xi + bur, nxi = lr * xi + li * xr + bui;
            xr = nxr; xi = nxi;
            float my = 0.f, myu = 0.f;
#pragma unroll
            for (int hh = 0; hh < 16; ++hh) {
                const float y = wave_sum(cr[hh] * xr - ci[hh] * xi);
                if (lane == hh) { my = y; myu = u[hh]; }
            }
            if (lane < 16) P.YS[(size_t)row * SW + g * 16 + lane] = f2bf(gelu_tanh(my + dd * myu));
        }
    }
}

#define GAS __attribute__((address_space(1)))
typedef short bf16x8 __attribute__((ext_vector_type(8)));
typedef unsigned u32x4 __attribute__((ext_vector_type(4)));
namespace pg8 {
constexpr int BM = 256, BK = 64, HALF = 128, HTB = HALF * BK * 2, STAGE_BYTES = 8 * HTB, NXCD = 8, WGM = 8;
__host__ __device__ __forceinline__ int lds_byte(int r, int c) { const int st = (r >> 4) * 2 + (c >> 5), rr = r & 15, cc = c & 31, ob = rr * 64 + cc * 2; return st * 1024 + (ob ^ (((ob >> 9) & 1) << 5)); }
__host__ __device__ __forceinline__ void stage_rc(int b, int& R, int& C) { const int st = b / 1024, sb = b % 1024, swz = sb ^ (((sb >> 9) & 1) << 5); R = (st >> 1) * 16 + swz / 64; C = (st & 1) * 32 + (swz % 64) / 2; }
__host__ __device__ __forceinline__ int perm32(int rho) { const int n = rho >> 4, i = rho & 15; return 8 * (i >> 2) + 4 * n + (i & 3); }
struct Unit { int pm, pn; };
struct Gemm { const bf16* A; const bf16* Bt; int lda, ldb, K, mg; };
struct StaticOrder {
    int nM, nN, nwg, G, c;
    __device__ void init(int M, int N, int G_, int c_) { nM = M / BM; nN = N / BM; nwg = nM * nN; G = G_; c = c_; }
    __device__ bool next(int i, Unit& u) const {
        const long L = (long)i * G + c; if (L >= nwg) return false;
        int wgid = (int)L; { const int q = nwg / NXCD, r = nwg % NXCD, xcd = wgid % NXCD, off = wgid / NXCD; wgid = (xcd < r ? xcd * (q + 1) : r * (q + 1) + (xcd - r) * q) + off; }
        const int nig = WGM * nN, gid = wgid / nig, fm = gid * WGM, gsz = (nM - fm) < WGM ? (nM - fm) : WGM;
        u.pm = fm + ((wgid % nig) % gsz); u.pn = (wgid % nig) / gsz; return true;
    }
    __device__ __forceinline__ int ntiles(const Unit&, int nt) const { return nt; }
    __device__ __forceinline__ int koff(const Unit&, int t) const { return t; }
};
__device__ __forceinline__ unsigned cvt_pk_bf16(float lo, float hi) { return cvtpk(lo, hi); }

template <class Epi, class Sched>
__device__ __forceinline__ void gemm_phase(LAS unsigned char* lds, const Gemm g, const Sched& S, const Epi& E) {
    const int tid = opaque_tid(), wid = __builtin_amdgcn_readfirstlane(tid >> 6), lane = tid & 63, wr = wid >> 2, wc = wid & 3, fr = lane & 15, fq = lane >> 4;
    const int K = g.K, nt = K / BK;
    unsigned voffA, voffB;
    { int R, C; stage_rc(tid * 16, R, C); const int Rb = (R & ~31) + perm32(R & 31); voffA = (unsigned)(R * g.lda + C) * 2u; voffB = (unsigned)(Rb * g.ldb + C) * 2u; }
    const size_t p2A = (size_t)64 * g.lda * 2, p2B = (size_t)64 * g.ldb * 2;
    const size_t kstep = (size_t)(BK * 2);
    const size_t hstepA = (size_t)HALF * g.lda * 2, hstepB = (size_t)HALF * g.ldb * 2;
    const size_t tstepA = 2 * hstepA, tstepB = 2 * hstepB;
    const unsigned ldsw = (unsigned)wid * 1024u;
    const int aoff = lds_byte(wr * 64 + fr, fq * 8), boff = lds_byte(wc * 32 + fr, fq * 8);
#define PG8_SA(b, h) (((b) * 2 + (h)) * HTB)
#define PG8_SB(b, h) ((4 + (b) * 2 + (h)) * HTB)
#define PG8_P2(v) PG8_P2_##v
#define PG8_P2_voffA p2A
#define PG8_P2_voffB p2B
#define PG8_STAGE(bufoff, gbase, voff) do { \
        __builtin_amdgcn_global_load_lds((const unsigned*)((const char*)(gbase) + (voff)), (LAS unsigned*)(lds + (bufoff) + ldsw), 16, 0, 0); \
        __builtin_amdgcn_global_load_lds((const unsigned*)((const char*)(gbase) + PG8_P2(voff) + (voff)), (LAS unsigned*)(lds + (bufoff) + ldsw + 8192), 16, 0, 0); } while (0)
#define PG8_LDA(dst, b, h) do { _Pragma("unroll") for (int m = 0; m < 4; ++m) _Pragma("unroll") for (int k = 0; k < 2; ++k) dst[m][k] = *(const LAS bf16x8*)(lds + PG8_SA(b, h) + aoff + m * 2048 + k * 1024); } while (0)
#define PG8_LDB(dst, b, h) do { _Pragma("unroll") for (int n = 0; n < 2; ++n) _Pragma("unroll") for (int k = 0; k < 2; ++k) dst[n][k] = *(const LAS bf16x8*)(lds + PG8_SB(b, h) + boff + n * 2048 + k * 1024); } while (0)
#define PG8_MMA(ai, bj, At, Bt) do { __builtin_amdgcn_s_setprio(1); _Pragma("unroll") for (int m = 0; m < 4; ++m) _Pragma("unroll") for (int n = 0; n < 2; ++n) _Pragma("unroll") for (int k = 0; k < 2; ++k) \
        acc[ai][bj][m][n] = __builtin_amdgcn_mfma_f32_16x16x32_bf16(Bt[n][k], At[m][k], acc[ai][bj][m][n], 0, 0, 0); __builtin_amdgcn_s_setprio(0); } while (0)
#define PG8_WAIT_V(n) asm volatile("s_waitcnt vmcnt(" #n ")" ::: "memory")
#define PG8_WAIT_L(n) asm volatile("s_waitcnt lgkmcnt(" #n ")" ::: "memory")
#define PG8_BAR __builtin_amdgcn_s_barrier()
#define PG8_SCHED __builtin_amdgcn_sched_barrier(0)
    Unit cur, nxt; int ui = 0;
    if (!S.next(0, cur)) return;
    int ntc = S.ntiles(cur, nt);
    f32x4 acc[2][2][4][2];
#pragma unroll
    for (int a = 0; a < 2; ++a)
#pragma unroll
        for (int b = 0; b < 2; ++b)
#pragma unroll
            for (int m = 0; m < 4; ++m)
#pragma unroll
                for (int n = 0; n < 2; ++n) acc[a][b][m][n] = (f32x4){0.f, 0.f, 0.f, 0.f};
    bf16x8 At[4][2], B0[2][2], B1[2][2];
    const char* cA = (const char*)g.A + (size_t)cur.pm * tstepA; const char* cB = (const char*)g.Bt + (size_t)((cur.pm / g.mg) * S.nN + cur.pn) * tstepB;
    PG8_STAGE(PG8_SB(0, 0), cB, voffB); PG8_STAGE(PG8_SB(0, 1), cB + hstepB, voffB); PG8_STAGE(PG8_SA(0, 0), cA, voffA); PG8_STAGE(PG8_SA(0, 1), cA + hstepA, voffA);
    if (wr == 1) PG8_BAR;
    PG8_WAIT_V(2); PG8_BAR;
    PG8_STAGE(PG8_SB(1, 0), cB + kstep, voffB); PG8_STAGE(PG8_SA(1, 0), cA + kstep, voffA); PG8_STAGE(PG8_SB(1, 1), cB + hstepB + kstep, voffB);
    PG8_WAIT_V(6); PG8_BAR;
    for (;;) {
        const bool has_next = S.next(ui + 1, nxt);
        const char* nA = has_next ? (const char*)g.A + (size_t)nxt.pm * tstepA : cA; const char* nB = has_next ? (const char*)g.Bt + (size_t)((nxt.pm / g.mg) * S.nN + nxt.pn) * tstepB : cB;
        for (int t = 0; t < ntc; t += 2) {
            const bool last = (t == ntc - 2);
            const size_t k1 = (size_t)S.koff(cur, t + 1) * kstep, k2 = (size_t)S.koff(cur, t + 2) * kstep, k3 = (size_t)S.koff(cur, t + 3) * kstep;
            const char* a1 = cA + k1;
            const char* a2 = last ? nA : cA + k2; const char* b2 = last ? nB : cB + k2;
            const char* a3 = last ? nA + kstep : cA + k3; const char* b3 = last ? nB + kstep : cB + k3;
            PG8_LDB(B0, 0, 0); PG8_LDB(B1, 0, 1); PG8_SCHED; PG8_LDA(At, 0, 0); PG8_STAGE(PG8_SA(1, 1), a1 + hstepA, voffA);
            PG8_WAIT_V(8); PG8_WAIT_L(0); PG8_BAR; PG8_MMA(0, 0, At, B0); PG8_MMA(0, 1, At, B1); PG8_BAR; PG8_SCHED;
            PG8_LDA(At, 0, 1); PG8_STAGE(PG8_SB(0, 0), b2, voffB); PG8_STAGE(PG8_SB(0, 1), b2 + hstepB, voffB); PG8_STAGE(PG8_SA(0, 0), a2, voffA);
            PG8_WAIT_V(8); PG8_WAIT_L(0); PG8_BAR; PG8_MMA(1, 0, At, B0); PG8_MMA(1, 1, At, B1); PG8_BAR; PG8_SCHED;
            PG8_LDB(B0, 1, 0); PG8_LDB(B1, 1, 1); PG8_SCHED; PG8_LDA(At, 1, 0); PG8_STAGE(PG8_SA(0, 1), a2 + hstepA, voffA);
            PG8_WAIT_V(8); PG8_WAIT_L(0); PG8_BAR; PG8_MMA(0, 0, At, B0); PG8_MMA(0, 1, At, B1); PG8_BAR; PG8_SCHED;
            PG8_LDA(At, 1, 1); PG8_STAGE(PG8_SB(1, 0), b3, voffB); PG8_STAGE(PG8_SB(1, 1), b3 + hstepB, voffB); PG8_STAGE(PG8_SA(1, 0), a3, voffA);
            PG8_WAIT_V(8); PG8_WAIT_L(0); PG8_BAR; PG8_MMA(1, 0, At, B0); PG8_MMA(1, 1, At, B1); PG8_BAR; PG8_SCHED;
        }
        if (wr == 0) PG8_BAR;
        E(acc, cur, wr, wc, fr, fq);
        if (!has_next) break;
#pragma unroll
        for (int a = 0; a < 2; ++a)
#pragma unroll
            for (int b = 0; b < 2; ++b)
#pragma unroll
                for (int m = 0; m < 4; ++m)
#pragma unroll
                    for (int n = 0; n < 2; ++n) acc[a][b][m][n] = (f32x4){0.f, 0.f, 0.f, 0.f};
        cur = nxt; cA = nA; cB = nB; ++ui; ntc = S.ntiles(cur, nt);
        if (wr == 1) PG8_BAR;
    }
    PG8_WAIT_V(0);
    PG8_BAR;
#undef PG8_SA
#undef PG8_SB
#undef PG8_STAGE
#undef PG8_LDA
#undef PG8_LDB
#undef PG8_MMA
#undef PG8_WAIT_V
#undef PG8_P2
#undef PG8_P2_voffA
#undef PG8_P2_voffB
#undef PG8_WAIT_L
#undef PG8_BAR
#undef PG8_SCHED
}
}

__device__ __forceinline__ u32x4 pack8(const f32x4 v0, const f32x4 v1) {
    u32x4 w; w.x = pg8::cvt_pk_bf16(v0[0], v0[1]); w.y = pg8::cvt_pk_bf16(v0[2], v0[3]); w.z = pg8::cvt_pk_bf16(v1[0], v1[1]); w.w = pg8::cvt_pk_bf16(v1[2], v1[3]); return w;
}
__device__ __forceinline__ f32x4 silu4(f32x4 v) { f32x4 r; r[0] = siluf(v[0]); r[1] = siluf(v[1]); r[2] = siluf(v[2]); r[3] = siluf(v[3]); return r; }
struct EpiInProj {
    static constexpr int NST = 16;
    bf16 *QKVR, *ZDN, *ZS, *UGX; float *BETA, *GLOG; const float *a_log, *dt_bias;
    __device__ __forceinline__ void operator()(const f32x4 (&acc)[2][2][4][2], const pg8::Unit& u, int wr, int wc, int fr, int fq) const {
        const int pn = u.pn, row0 = u.pm * 256 + wr * 64 + fr, cw = wc * 32 + 8 * fq;
#pragma unroll
        for (int ai = 0; ai < 2; ++ai)
#pragma unroll
            for (int m = 0; m < 4; ++m) {
                const int row = row0 + ai * 128 + m * 16;
#pragma unroll
                for (int bj = 0; bj < 2; ++bj) {
                    f32x4 v0 = acc[ai][bj][m][0], v1 = acc[ai][bj][m][1];
                    const int ct = bj * 128 + cw;
                    bf16* dst;
                    if (pn < 6) dst = QKVR + (size_t)row * QKV + pn * 256 + ct;
                    else if (pn < 8) { v0 = silu4(v0); v1 = silu4(v1); dst = ZDN + (size_t)row * 512 + (pn - 6) * 256 + ct; }
                    else if (pn < 10) { const int c = (pn - 8) * 256 + ct; dst = UGX + ((size_t)(c >> 4) * 1024 + (row >> 6)) * UGX_LD + (row & 63) * 16 + (c & 15); }
                    else { v0 = silu4(v0); v1 = silu4(v1); dst = ZS + (size_t)row * 512 + (pn - 10) * 256 + ct; }
                    *(u32x4*)dst = pack8(v0, v1);
                }
            }
    }
};
struct EpiGlu {
    static constexpr int NST = 8;
    bf16* MIXIN; const bf16* ZS; const float* glu_b;
    __device__ __forceinline__ void operator()(const f32x4 (&acc)[2][2][4][2], const pg8::Unit& u, int wr, int wc, int fr, int fq) const {
        const int row0 = u.pm * 256 + wr * 64 + fr, col = u.pn * 128 + wc * 32 + 8 * fq;
        const f32x4 bv0 = *(const f32x4*)(glu_b + col), bv1 = *(const f32x4*)(glu_b + col + 4), bg0 = *(const f32x4*)(glu_b + 512 + col), bg1 = *(const f32x4*)(glu_b + 512 + col + 4);
#pragma unroll
        for (int ai = 0; ai < 2; ++ai)
#pragma unroll
            for (int m = 0; m < 4; ++m) {
                const int row = row0 + ai * 128 + m * 16;
                const u32x4 z = *(const u32x4*)(ZS + (size_t)row * 512 + col);
                const f32x4 a0 = acc[ai][0][m][0] + bv0, a1 = acc[ai][0][m][1] + bv1, g0 = acc[ai][1][m][0] + bg0, g1 = acc[ai][1][m][1] + bg1;
                f32x4 o0, o1;
                o0[0] = a0[0] * sigmf(g0[0]) * bf2f((bf16)(z.x & 0xffff)); o0[1] = a0[1] * sigmf(g0[1]) * bf2f((bf16)(z.x >> 16));
                o0[2] = a0[2] * sigmf(g0[2]) * bf2f((bf16)(z.y & 0xffff)); o0[3] = a0[3] * sigmf(g0[3]) * bf2f((bf16)(z.y >> 16));
                o1[0] = a1[0] * sigmf(g1[0]) * bf2f((bf16)(z.z & 0xffff)); o1[1] = a1[1] * sigmf(g1[1]) * bf2f((bf16)(z.z >> 16));
                o1[2] = a1[2] * sigmf(g1[2]) * bf2f((bf16)(z.w & 0xffff)); o1[3] = a1[3] * sigmf(g1[3]) * bf2f((bf16)(z.w >> 16));
                *(u32x4*)(MIXIN + (size_t)row * D + 512 + col) = pack8(o0, o1);
            }
    }
};
struct EpiOut {
    static constexpr int NST = 24;
    bf16* MIXO; float* SSQ;
    __device__ __forceinline__ void operator()(const f32x4 (&acc)[2][2][4][2], const pg8::Unit& u, int wr, int wc, int fr, int fq) const {
        const int row0 = u.pm * 256 + wr * 64 + fr, col0 = u.pn * 256 + wc * 32 + 8 * fq;
#pragma unroll
        for (int ai = 0; ai < 2; ++ai)
#pragma unroll
            for (int m = 0; m < 4; ++m) {
                const int row = row0 + ai * 128 + m * 16;
                float s = 0.f;
#pragma unroll
                for (int bj = 0; bj < 2; ++bj) {
                    const f32x4 v0 = acc[ai][bj][m][0], v1 = acc[ai][bj][m][1];
                    s += (v0[0] * v0[0] + v0[1] * v0[1]) + (v0[2] * v0[2] + v0[3] * v0[3]) + (v1[0] * v1[0] + v1[1] * v1[1]) + (v1[2] * v1[2] + v1[3] * v1[3]);
                    *(u32x4*)(MIXO + (size_t)row * D + col0 + bj * 128) = pack8(v0, v1);
                }
                s += __shfl_xor(s, 16); s += __shfl_xor(s, 32);
                if (fq == 0) SSQ[(size_t)row * 16 + u.pn * 4 + wc] = s;
            }
    }
};

__device__ __forceinline__ unsigned pk2(float lo, float hi) { return cvtpk(lo, hi); }
template <int KIND> __device__ __forceinline__ int wsrc(int n) {
    if (KIND == 0) return n < 2048 ? n : n + 8;
    if (KIND == 1) { const int pn = n >> 8, j = n & 255; return j < 128 ? pn * 128 + j : 512 + pn * 128 + (j - 128); }
    return n;
}
template <int KIND>
__device__ __forceinline__ void transpose_item(const float* W, int K, int N, bf16* WT, LAS float* scr, int item, int nblk, int lane) {
    const int kb = item / nblk, nb = item % nblk, k0 = 64 * kb, n0 = 32 * nb;
    const int sc = wsrc<KIND>(n0 + (lane & 31));
#pragma unroll 8
    for (int i = 0; i < 32; ++i) { const int kk = 2 * i + (lane >> 5); scr[kk * 33 + (lane & 31)] = sc >= 0 ? W[(size_t)(k0 + kk) * N + sc] : 0.f; }
    asm volatile("s_waitcnt lgkmcnt(0)" ::: "memory");
    const int c = lane & 7;
#pragma unroll
    for (int j = 0; j < 4; ++j) { const int n = (lane >> 3) + 8 * j; const LAS float* s = scr + (8 * c) * 33 + n;
        u32x4 o; o.x = pk2(s[0 * 33], s[1 * 33]); o.y = pk2(s[2 * 33], s[3 * 33]); o.z = pk2(s[4 * 33], s[5 * 33]); o.w = pk2(s[6 * 33], s[7 * 33]);
        *(u32x4*)(WT + (size_t)(n0 + n) * K + k0 + 8 * c) = o; }
    asm volatile("s_waitcnt lgkmcnt(0)" ::: "memory");
}
__device__ __forceinline__ void prologue_weights(LAS unsigned char* lds, const Ptrs& P, unsigned char* ws) {
    const int BID = opaque_bid(), GRD = opaque_grid(); (void)BID; (void)GRD;
    const int tid_ = opaque_tid(); const int lane = tid_ & 63, wave = __builtin_amdgcn_readfirstlane(tid_ >> 6);
    LAS float* scr = (LAS float*)(lds + wave * 16384);
    const int gw = BID * NWAVES + wave, ngw = GRD * NWAVES;
    constexpr int I_IN = (D / 64) * (3072 / 32), I_GLU = (SW / 64) * (1024 / 32), I_OUT = (D / 64) * (D / 32);
    constexpr int PER = I_IN + I_GLU + I_OUT;
    for (int it = gw; it < DEPTH * PER; it += ngw) {
        const int l = it / PER; int r = it % PER;
        if (r < I_IN) { transpose_item<0>(P.w_in + (size_t)l * D * INC, D, INC, (bf16*)(ws + WS_WIN) + (size_t)l * 3072 * D, scr, r, 3072 / 32, lane); continue; } r -= I_IN;
        if (r < I_GLU) { transpose_item<1>(P.glu_w + (size_t)l * SW * 1024, SW, 1024, (bf16*)(ws + WS_WGLU) + (size_t)l * 1024 * SW, scr, r, 1024 / 32, lane); continue; } r -= I_GLU;
        transpose_item<2>(P.w_out + (size_t)l * D * D, D, D, (bf16*)(ws + WS_WOUT) + (size_t)l * D * D, scr, r, D / 32, lane);
    }
}

__device__ __forceinline__ float gelu_fast(float x) { return x * __builtin_amdgcn_rcpf(1.f + __expf(-1.5957691216057308f * (x + 0.044715f * x * x * x))); }
__device__ __forceinline__ void s5_lambda(const Ptrs& P, int l, int g, int p, int tau, float& lr, float& li) {
    const float dt = __expf(P.log_dt[l * NG + g]);
    const float are = P.a_re[(size_t)(l * NG + g) * SP + p], aim = P.a_im[(size_t)(l * NG + g) * SP + p];
    const float mag = __expf((float)tau * are * dt);
    const double rev = (double)tau * (double)aim * (double)dt * 0.15915494309189535;
    const float fr = (float)(rev - rint(rev));
    lr = mag * __cosf(fr * 6.283185307179586f); li = mag * __sinf(fr * 6.283185307179586f);
}
__device__ __forceinline__ void s5_build(LAS unsigned char* lds, const Ptrs& P, int l, bf16* TF, bf16* WE, float* KTAB) {
    const int BID = opaque_bid(), GRD = opaque_grid(); (void)BID; (void)GRD;
    LAS float* LTr = (LAS float*)lds;
    LAS float* LTi = LTr + 65 * 64;
    LAS float* CR = LTi + 65 * 64;
    LAS float* CI = CR + 16 * 64;
    LAS float* BBR = CI + 16 * 64;
    LAS float* BBI = BBR + 64 * 16;
    const int tid = opaque_tid();
    for (int item = BID; item < NG * 8; item += GRD) {
        const int g = item >> 3, part = item & 7;
        __syncthreads();
        for (int e = tid; e < 65 * 64; e += NTHREADS) { float lr, li; s5_lambda(P, l, g, e & 63, e >> 6, lr, li); LTr[e] = lr; LTi[e] = li; }
        if (tid < 64) {
            const int p = tid;
            const float are = P.a_re[(size_t)(l * NG + g) * SP + p], aim = P.a_im[(size_t)(l * NG + g) * SP + p];
            float lr, li; s5_lambda(P, l, g, p, 1, lr, li);
            const float den = are * are + aim * aim, nr = lr - 1.f, ni = li;
            const float cfr = (nr * are + ni * aim) / den, cfi = (ni * are - nr * aim) / den;
#pragma unroll
            for (int hh = 0; hh < 16; ++hh) {
                const float br = P.b_re[((size_t)(l * NG + g) * SP + p) * 16 + hh], bi = P.b_im[((size_t)(l * NG + g) * SP + p) * 16 + hh];
                BBR[p * 16 + hh] = cfr * br - cfi * bi; BBI[p * 16 + hh] = cfr * bi + cfi * br;
                CR[hh * 64 + p] = P.c_re[((size_t)(l * NG + g) * 16 + hh) * SP + p]; CI[hh * 64 + p] = P.c_im[((size_t)(l * NG + g) * 16 + hh) * SP + p];
            }
        }
        __syncthreads();
        for (int q = 0; q < 4; ++q) {
            const int e = tid + NTHREADS * q, tau = part * 8 + (e >> 8), h = (e >> 4) & 15, hp = e & 15;
            float s = 0.f;
#pragma unroll 8
            for (int p = 0; p < 64; ++p) {
                const float cr = CR[h * 64 + p], ci = CI[h * 64 + p], Lr = LTr[tau * 64 + p], Li = LTi[tau * 64 + p];
                s += (cr * Lr - ci * Li) * BBR[p * 16 + hp] - (cr * Li + ci * Lr) * BBI[p * 16 + hp];
            }
            if (tau == 0 && h == hp) s += P.sd[l * SW + g * 16 + h];
            KTAB[((size_t)g * 64 + tau) * 256 + h * 16 + hp] = s;
        }
        bf16* TFg = TF + (size_t)g * 1024 * UGX_LD;
        for (int e = tid; e < 128 * 16; e += NTHREADS) {
            const int rl = e >> 4, ck = e & 15, n = part * 128 + rl, i = n >> 4, h = n & 15, pp0 = ck * 8;
            float v[8];
#pragma unroll
            for (int x = 0; x < 8; ++x) {
                const int pp = pp0 + x, p = pp & 63;
                const float cr = CR[h * 64 + p], ci = CI[h * 64 + p], Lr = LTr[(i + 1) * 64 + p], Li = LTi[(i + 1) * 64 + p];
                v[x] = pp < 64 ? (cr * Lr - ci * Li) : -(cr * Li + ci * Lr);
            }
            u32x4 w; w.x = pk2(v[0], v[1]); w.y = pk2(v[2], v[3]); w.z = pk2(v[4], v[5]); w.w = pk2(v[6], v[7]);
            *(u32x4*)(TFg + (size_t)n * UGX_LD + 1024 + ck * 8) = w;
        }
        bf16* WEg = WE + (size_t)g * 256 * 1024;
        for (int e = tid; e < 16 * 128; e += NTHREADS) {
            const int rl = e >> 7, ck = e & 127, nn = part * 16 + rl, p = nn & 63, j = ck >> 1, hp0 = (ck & 1) * 8;
            const float Lr = LTr[(63 - j) * 64 + p], Li = LTi[(63 - j) * 64 + p];
            float v[8];
#pragma unroll
            for (int x = 0; x < 8; ++x) { const float br = BBR[p * 16 + hp0 + x], bi = BBI[p * 16 + hp0 + x]; v[x] = nn < 64 ? (Lr * br - Li * bi) : (Lr * bi + Li * br); }
            u32x4 w; w.x = pk2(v[0], v[1]); w.y = pk2(v[2], v[3]); w.z = pk2(v[4], v[5]); w.w = pk2(v[6], v[7]);
            *(u32x4*)(WEg + (size_t)nn * 1024 + ck * 8) = w;
        }
    }
    __syncthreads();
}
__device__ __forceinline__ void s5_expand(bf16* TF, const float* KTAB) {
    const int BID = opaque_bid(), GRD = opaque_grid();
    const int tid = opaque_tid();
    const unsigned nthr = (unsigned)GRD * NTHREADS;
    for (unsigned e0 = (unsigned)BID * NTHREADS + tid; e0 < (unsigned)NG * 1024u * 128u; e0 += 4u * nthr) {
        f32x4 a[4], c[4]; bool ok[4];
#pragma unroll
        for (int u = 0; u < 4; ++u) {
            const unsigned e = e0 + (unsigned)u * nthr;
            const int ck = e & 127, n = (e >> 7) & 1023, g = e >> 17, i = n >> 4, h = n & 15, j = ck >> 1, hp0 = (ck & 1) * 8;
            ok[u] = e < (unsigned)NG * 1024u * 128u && j <= i;
            const float* src = KTAB + ((size_t)g * 64 + (ok[u] ? i - j : 0)) * 256 + h * 16 + hp0;
            if (ok[u]) { a[u] = *(const f32x4*)src; c[u] = *(const f32x4*)(src + 4); } else { a[u] = (f32x4){0.f, 0.f, 0.f, 0.f}; c[u] = a[u]; }
        }
#pragma unroll
        for (int u = 0; u < 4; ++u) {
            const unsigned e = e0 + (unsigned)u * nthr;
            if (e < (unsigned)NG * 1024u * 128u && (int)((e & 127) >> 5) <= (int)(((e >> 7) & 1023) >> 8)) {
                const int ck = e & 127, n = (e >> 7) & 1023, g = e >> 17;
                u32x4 w; w.x = pk2(a[u][0], a[u][1]); w.y = pk2(a[u][2], a[u][3]); w.z = pk2(c[u][0], c[u][1]); w.w = pk2(c[u][2], c[u][3]);
                *(u32x4*)(TF + ((size_t)g * 1024 + n) * UGX_LD + ck * 8) = w;
            }
        }
    }
}
struct EpiEst {
    static constexpr int NST = 16;
    float* EST;
    __device__ __forceinline__ void operator()(const f32x4 (&acc)[2][2][4][2], const pg8::Unit& u, int wr, int wc, int fr, int fq) const {
        const int row0 = u.pm * 256 + wr * 64 + fr, col = wc * 32 + 8 * fq;
#pragma unroll
        for (int ai = 0; ai < 2; ++ai)
#pragma unroll
            for (int m = 0; m < 4; ++m) { float* d = EST + (size_t)(row0 + ai * 128 + m * 16) * 128 + col; *(f32x4*)d = acc[ai][0][m][0]; *(f32x4*)(d + 4) = acc[ai][0][m][1]; }
    }
};
struct S5Order {
    int nN, cnt, c;
    __device__ bool next(int i, pg8::Unit& u) const { const int pm = (i >> 2) * cnt + c; if (c < 0 || pm >= NG * 4) return false; u.pm = pm; u.pn = i & 3; return true; }
    __device__ __forceinline__ int ntiles(const pg8::Unit& u, int) const { return 4 * (u.pn + 1) + 2; }
    __device__ __forceinline__ int koff(const pg8::Unit& u, int t) const { const int km = 4 * (u.pn + 1); return t < km ? t : t + 16 - km; }
};
struct S5EOrder {
    int nN, cnt, c;
    __device__ bool next(int i, pg8::Unit& u) const { const int pm = i * cnt + c; if (c < 0 || pm >= NG * 4) return false; u.pm = pm; u.pn = 0; return true; }
    __device__ __forceinline__ int ntiles(const pg8::Unit&, int nt) const { return nt; }
    __device__ __forceinline__ int koff(const pg8::Unit&, int t) const { return t; }
};
__device__ __forceinline__ void s5_carry(const Ptrs& P, int l, int pm, const float* EST, bf16* UGX, int tid) {
    const int g = pm >> 2, bl = tid >> 6, p = tid & 63;
    float lr, li; s5_lambda(P, l, g, p, 64, lr, li);
    float xr = 0.f, xi = 0.f;
    const size_t row0 = (size_t)pm * 256 + bl * 32;
#pragma unroll 4
    for (int c = 0; c < 32; ++c) {
        const size_t row = row0 + c;
        UGX[row * UGX_LD + 1024 + p] = f2bf(xr); UGX[row * UGX_LD + 1088 + p] = f2bf(xi);
        const float er = __hip_atomic_load(EST + row * 128 + p, __ATOMIC_RELAXED, __HIP_MEMORY_SCOPE_AGENT), ei = __hip_atomic_load(EST + row * 128 + 64 + p, __ATOMIC_RELAXED, __HIP_MEMORY_SCOPE_AGENT);
        const float nr = lr * xr - li * xi + er, ni = lr * xi + li * xr + ei;
        xr = nr; xi = ni;
    }
}
struct EpiS5 {
    static constexpr int NST = 16;
    bf16* YS;
    __device__ __forceinline__ void operator()(const f32x4 (&acc)[2][2][4][2], const pg8::Unit& u, int wr, int wc, int fr, int fq) const {
        const int g = u.pm >> 2, rg0 = (u.pm & 3) * 256 + wr * 64 + fr;
#pragma unroll
        for (int ai = 0; ai < 2; ++ai)
#pragma unroll
            for (int m = 0; m < 4; ++m) {
                const int rg = rg0 + ai * 128 + m * 16;
                const size_t tok0 = (size_t)(rg >> 5) * SEQ + (rg & 31) * 64;
#pragma unroll
                for (int bj = 0; bj < 2; ++bj) {
                    const int col = u.pn * 256 + bj * 128 + wc * 32 + 8 * fq, i = col >> 4, h0 = col & 15;
                    f32x4 v0 = acc[ai][bj][m][0], v1 = acc[ai][bj][m][1];
#pragma unroll
                    for (int x = 0; x < 4; ++x) { v0[x] = gelu_fast(v0[x]); v1[x] = gelu_fast(v1[x]); }
                    *(u32x4*)(YS + (tok0 + i) * SW + g * 16 + h0) = pack8(v0, v1);
                }
            }
    }
};

typedef float f32x16 __attribute__((ext_vector_type(16)));
typedef unsigned u32x2 __attribute__((ext_vector_type(2)));
#define MFMA32(a, b, c) __builtin_amdgcn_mfma_f32_32x32x16_bf16((a), (b), (c), 0, 0, 0)
__device__ __forceinline__ bf16x8 ldf(const LAS unsigned char* base, int row, int ldb, int kb) { return *(const LAS bf16x8*)(base + row * ldb + kb); }
__device__ __forceinline__ int crow(int reg, int h) { return (reg & 3) + 8 * (reg >> 2) + 4 * h; }
__device__ __forceinline__ void unpack8(const u32x4 v, float* d) {
    d[0] = bf2f((bf16)(v.x & 0xffff)); d[1] = bf2f((bf16)(v.x >> 16)); d[2] = bf2f((bf16)(v.y & 0xffff)); d[3] = bf2f((bf16)(v.y >> 16));
    d[4] = bf2f((bf16)(v.z & 0xffff)); d[5] = bf2f((bf16)(v.z >> 16)); d[6] = bf2f((bf16)(v.w & 0xffff)); d[7] = bf2f((bf16)(v.w >> 16));
}
struct DnBufs { bf16 *UT, *W, *QG, *KDT, *INTRA; float* GLAST; };
constexpr int NITEM = BATCH * NH * (SEQ / 64);

__device__ __forceinline__ void dn_chunk(LAS unsigned char* lds, const Ptrs& P, int l, const DnBufs& B, bf16* TF, const float* KTAB) {
    const int BID = opaque_bid(), GRD = opaque_grid(); (void)BID; (void)GRD;
    LAS unsigned char* Kt = lds;
    LAS unsigned char* Qt = Kt + 17408;
    LAS unsigned char* KgT = Qt + 17408;
    LAS unsigned char* VbT = KgT + 18432;
    LAS unsigned char* KdT = VbT + 18432;
    LAS float* Am = (LAS float*)(KdT + 18432);
    LAS unsigned char* Tm = (LAS unsigned char*)Am + 17408;
    LAS unsigned char* AoT = Tm + 9216;
    LAS unsigned char* Dm = AoT + 9216;
    LAS unsigned char* DmT = Dm + 9216;
    LAS float* gcs = (LAS float*)(DmT + 9216);
    LAS float* bts = gcs + 64;
    LAS float* cws = bts + 64;
    LAS unsigned char* const RW0 = (LAS unsigned char*)Am, * const RW1 = Tm, * const RW2 = Dm;
    LAS unsigned char* Nm = Kt, *NT = Kt + 9216, *INm = Qt, *ZT = (LAS unsigned char*)Am, *Pm = Kt;
    const int tid0 = opaque_tid(), wave = __builtin_amdgcn_readfirstlane(tid0 >> 6);
    int tid = tid0, lane = tid0 & 63, h32 = lane >> 5, l31 = lane & 31;
#define REOPQ do { tid = tid0; asm volatile("" : "+v"(tid)); lane = tid & 63; h32 = lane >> 5; l31 = lane & 31; } while (0)
    int cur_hh = -1;
    u32x4 own[3][2], hal[3][2];
#define DN_LOAD_RAW(it_) do { const int it__ = (it_); const int chunk_ = it__ & 31, bh_ = it__ >> 5, hh_ = bh_ & 3, b_ = bh_ >> 2, row0_ = b_ * SEQ + chunk_ * 64; \
        const int r_ = tid >> 3, cg_ = tid & 7; \
        _Pragma("unroll") for (int part = 0; part < 3; ++part) { \
            const bf16* src = P.QKVR + (size_t)(row0_ + r_) * QKV + part * 512 + hh_ * 128 + cg_ * 16; \
            own[part][0] = *(const u32x4*)src; own[part][1] = *(const u32x4*)(src + 8); \
            if (r_ < 3 && chunk_ != 0) { const bf16* hs = src - (size_t)3 * QKV; hal[part][0] = *(const u32x4*)hs; hal[part][1] = *(const u32x4*)(hs + 8); } } } while (0)
    if (BID < NITEM) DN_LOAD_RAW(BID);
    float g_pf = 0.f, b_pf = 0.f;
    if (BID < NITEM && wave == 0) { const int bh2 = BID >> 5, r2 = (bh2 >> 2) * SEQ + (BID & 31) * 64 + lane; g_pf = P.GLOG[(size_t)r2 * 4 + (bh2 & 3)]; b_pf = P.BETA[(size_t)r2 * 4 + (bh2 & 3)]; }
    constexpr unsigned XTOT = (unsigned)NG * 1024u * 128u;
    const unsigned xnthr = (unsigned)GRD * NTHREADS, xgid = (unsigned)BID * NTHREADS + (unsigned)tid0, xsteps = (XTOT + xnthr - 1) / xnthr;
    unsigned xu = 0;
#define DN_XDEC(e_) const int ck = (e_) & 127, n = ((e_) >> 7) & 1023, g = ((e_) >> 17) & (NG - 1), i = n >> 4, h = n & 15, j = ck >> 1, hp0 = (ck & 1) * 8; \
        const bool need = (e_) < XTOT && (ck >> 5) <= (n >> 8), ok = j <= i; (void)need; (void)ok; (void)g; (void)h; (void)hp0
    for (int item = BID; item < NITEM; item += GRD) {
        REOPQ;
        const int chunk = item & 31, bh = item >> 5, hh = bh & 3, b = bh >> 2, row0 = b * SEQ + chunk * 64;
        f32x4 xa[2], xc[2];
#pragma unroll
        for (int q = 0; q < 2; ++q) {
            const unsigned e = xgid + (xu + (unsigned)q) * xnthr; DN_XDEC(e);
            const float* src = KTAB + ((size_t)g * 64 + (ok ? i - j : 0)) * 256 + h * 16 + hp0;
            xa[q] = *(const f32x4*)src; xc[q] = *(const f32x4*)(src + 4);
        }
        if (hh != cur_hh) {
            cur_hh = hh;
            for (int e = tid; e < 3 * 4 * 128; e += NTHREADS) { const int part = e >> 9, j = (e >> 7) & 3, c = e & 127; cws[e] = P.conv_w[(size_t)(l * 4 + j) * QKV + part * 512 + hh * 128 + c]; }
        }
        if (wave == 0) {
            float g = g_pf;
            g = wave_scan_incl(g);
            gcs[lane] = g; bts[lane] = b_pf;
            if (lane == 63) B.GLAST[item] = __expf(g);
            if (item + GRD < NITEM) { const int it2 = item + GRD, bh2 = it2 >> 5, r2 = (bh2 >> 2) * SEQ + (it2 & 31) * 64 + lane; g_pf = P.GLOG[(size_t)r2 * 4 + (bh2 & 3)]; b_pf = P.BETA[(size_t)r2 * 4 + (bh2 & 3)]; }
        }
        {
            const int r_ = tid >> 3, cg_ = tid & 7;
#pragma unroll
            for (int part = 0; part < 3; ++part) {
                LAS unsigned char* rw = part == 0 ? RW0 : (part == 1 ? RW1 : RW2);
                *(LAS u32x4*)(rw + (3 + r_) * 256 + cg_ * 32) = own[part][0]; *(LAS u32x4*)(rw + (3 + r_) * 256 + cg_ * 32 + 16) = own[part][1];
                if (r_ < 3) {
                    const u32x4 z4 = (u32x4){0u, 0u, 0u, 0u};
                    *(LAS u32x4*)(rw + r_ * 256 + cg_ * 32) = chunk != 0 ? hal[part][0] : z4; *(LAS u32x4*)(rw + r_ * 256 + cg_ * 32 + 16) = chunk != 0 ? hal[part][1] : z4;
                }
            }
        }
        const int r = tid >> 3, cg = tid & 7;
        __syncthreads(); REOPQ;
        {
            const float gc_r = gcs[r], beta_r = bts[r], glast = gcs[63];
            const float eg = __expf(gc_r), ed = __expf(glast - gc_r);
#pragma unroll
            for (int part = 0; part < 3; ++part) {
                float acc[16];
#pragma unroll
                for (int c = 0; c < 16; ++c) acc[c] = 0.f;
#pragma unroll
                for (int j = 0; j < 4; ++j) {
                    const LAS unsigned char* rw = (part == 0 ? RW0 : (part == 1 ? RW1 : RW2)) + (r + j) * 256 + cg * 32;
                    float x[16]; unpack8(*(const LAS u32x4*)rw, x); unpack8(*(const LAS u32x4*)(rw + 16), x + 8);
                    const LAS float* wp = cws + (part * 4 + j) * 128 + cg * 16;
#pragma unroll
                    for (int c4 = 0; c4 < 4; ++c4) { const f32x4 w = *(const LAS f32x4*)(wp + 4 * c4);
                        acc[4 * c4] += w[0] * x[4 * c4]; acc[4 * c4 + 1] += w[1] * x[4 * c4 + 1]; acc[4 * c4 + 2] += w[2] * x[4 * c4 + 2]; acc[4 * c4 + 3] += w[3] * x[4 * c4 + 3]; }
                }
                float ss = 0.f;
#pragma unroll
                for (int c = 0; c < 16; ++c) { acc[c] = siluf(acc[c]); ss += acc[c] * acc[c]; }
                if (part < 2) {
                    ss = sum8_dpp(ss);
                    const float rinv = __builtin_amdgcn_rsqf(ss + EPS) * (part == 0 ? 0.08838834764831845f : 1.f);
#pragma unroll
                    for (int c = 0; c < 16; ++c) acc[c] *= rinv;
                }
                if (part == 0) {
                    u32x4 w0, w1;
                    w0.x = pk2(acc[0], acc[1]); w0.y = pk2(acc[2], acc[3]); w0.z = pk2(acc[4], acc[5]); w0.w = pk2(acc[6], acc[7]);
                    w1.x = pk2(acc[8], acc[9]); w1.y = pk2(acc[10], acc[11]); w1.z = pk2(acc[12], acc[13]); w1.w = pk2(acc[14], acc[15]);
                    *(LAS u32x4*)(Qt + r * 272 + cg * 32) = w0; *(LAS u32x4*)(Qt + r * 272 + cg * 32 + 16) = w1;
                    u32x4 g0, g1;
                    g0.x = pk2(acc[0] * eg, acc[1] * eg); g0.y = pk2(acc[2] * eg, acc[3] * eg); g0.z = pk2(acc[4] * eg, acc[5] * eg); g0.w = pk2(acc[6] * eg, acc[7] * eg);
                    g1.x = pk2(acc[8] * eg, acc[9] * eg); g1.y = pk2(acc[10] * eg, acc[11] * eg); g1.z = pk2(acc[12] * eg, acc[13] * eg); g1.w = pk2(acc[14] * eg, acc[15] * eg);
                    bf16* qg = B.QG + (size_t)item * 8192 + r * 128 + cg * 16;
                    *(u32x4*)qg = g0; *(u32x4*)(qg + 8) = g1;
                } else if (part == 1) {
                    u32x4 w0, w1;
                    w0.x = pk2(acc[0], acc[1]); w0.y = pk2(acc[2], acc[3]); w0.z = pk2(acc[4], acc[5]); w0.w = pk2(acc[6], acc[7]);
                    w1.x = pk2(acc[8], acc[9]); w1.y = pk2(acc[10], acc[11]); w1.z = pk2(acc[12], acc[13]); w1.w = pk2(acc[14], acc[15]);
                    *(LAS u32x4*)(Kt + r * 272 + cg * 32) = w0; *(LAS u32x4*)(Kt + r * 272 + cg * 32 + 16) = w1;
                    const float sg = beta_r * eg;
                    const int swz = (((r >> 3) ^ cg) & 7) * 16 + (r & 7) * 2;
#pragma unroll
                    for (int c = 0; c < 16; c += 2) {
                        const unsigned wg = cvtpk(acc[c] * sg, acc[c + 1] * sg), wd = cvtpk(acc[c] * ed, acc[c + 1] * ed);
                        *(LAS bf16*)(KgT + (cg * 16 + c) * 144 + swz) = (bf16)(wg & 0xffffu); *(LAS bf16*)(KgT + (cg * 16 + c + 1) * 144 + swz) = (bf16)(wg >> 16);
                        *(LAS bf16*)(KdT + (cg * 16 + c) * 144 + swz) = (bf16)(wd & 0xffffu); *(LAS bf16*)(KdT + (cg * 16 + c + 1) * 144 + swz) = (bf16)(wd >> 16);
                    }
                } else {
                    const int swz = (((r >> 3) ^ cg) & 7) * 16 + (r & 7) * 2;
#pragma unroll
                    for (int c = 0; c < 16; c += 2) { const unsigned wv = cvtpk(acc[c] * beta_r, acc[c + 1] * beta_r);
                        *(LAS bf16*)(VbT + (cg * 16 + c) * 144 + swz) = (bf16)(wv & 0xffffu); *(LAS bf16*)(VbT + (cg * 16 + c + 1) * 144 + swz) = (bf16)(wv >> 16); }
                }
            }
        }
        __builtin_amdgcn_sched_barrier(0);
        if (item + GRD < NITEM) DN_LOAD_RAW(item + GRD);
        __syncthreads(); REOPQ;
        for (int e = tid; e < 2 * 9216 / 16; e += NTHREADS) *(LAS u32x4*)(Dm + e * 16) = (u32x4){0u, 0u, 0u, 0u};
        if (wave < 4) {
            const int ti = wave >> 1, tj = wave & 1;
            f32x16 acc;
#pragma unroll
            for (int x = 0; x < 16; ++x) acc[x] = 0.f;
            if (!(ti == 0 && tj == 1)) {
#pragma unroll
                for (int s = 0; s < 8; ++s) { const bf16x8 a = ldf(Kt, ti * 32 + l31, 272, s * 32 + h32 * 16), bq = ldf(Kt, tj * 32 + l31, 272, s * 32 + h32 * 16); acc = MFMA32(a, bq, acc); }
            }
            const int j = tj * 32 + l31; const float gj = gcs[j];
#pragma unroll
            for (int q = 0; q < 4; ++q) {
                const int i0 = ti * 32 + 8 * q + 4 * h32;
                float v[4];
#pragma unroll
                for (int k = 0; k < 4; ++k) { const int i = i0 + k; const float t = bts[i] * acc[4 * q + k] * __expf(gcs[i] - gj); v[k] = (i > j) ? t : 0.f; Am[i * 68 + j] = v[k]; }
                const bool off = (i0 >> 4) > (j >> 4);
                u32x2 w; w.x = off ? pk2(v[0], v[1]) : 0u; w.y = off ? pk2(v[2], v[3]) : 0u;
                *(LAS u32x2*)(AoT + j * 144 + i0 * 2) = w;
            }
        } else {
            const int w4 = wave - 4, ib = w4 >> 1, jb = w4 & 1;
            f32x16 acc;
#pragma unroll
            for (int x = 0; x < 16; ++x) acc[x] = 0.f;
            if (!(ib == 0 && jb == 1)) {
#pragma unroll
                for (int s = 0; s < 8; ++s) { const bf16x8 a = ldf(Kt, jb * 32 + l31, 272, s * 32 + h32 * 16), bq = ldf(Qt, ib * 32 + l31, 272, s * 32 + h32 * 16); acc = MFMA32(a, bq, acc); }
            }
            const int i = ib * 32 + l31; const float gi = gcs[i];
            bf16* dst = B.INTRA + (size_t)item * 4096 + i * 64 + jb * 32;
#pragma unroll
            for (int q = 0; q < 4; ++q) {
                float v[4];
#pragma unroll
                for (int k = 0; k < 4; ++k) { const int j = jb * 32 + 8 * q + 4 * h32 + k; const float t = acc[4 * q + k] * __expf(gi - gcs[j]); v[k] = (i >= j) ? t : 0.f; }
                u32x2 w; w.x = pk2(v[0], v[1]); w.y = pk2(v[2], v[3]);
                *(u32x2*)(dst + 8 * q + 4 * h32) = w;
            }
        }
        {
            const int rr = tid >> 2, sg = tid & 3;
            const int xs = (rr >> 4) & 7;
            const u32x4 a = *(const LAS u32x4*)(KdT + rr * 144 + ((2 * sg) ^ xs) * 16), c = *(const LAS u32x4*)(KdT + rr * 144 + ((2 * sg + 1) ^ xs) * 16);
            bf16* d = B.KDT + (size_t)item * 8192 + rr * 64 + sg * 16;
            *(u32x4*)d = a; *(u32x4*)(d + 8) = c;
        }
        __syncthreads(); REOPQ;
        if (wave == 0) {
            const int blk = lane >> 4, c = lane & 15;
            const LAS float* Ab = Am + (16 * blk) * 68 + 16 * blk;
            float Dc[16];
            f32x4 rb[2][4];
            rb[1][0] = *(const LAS f32x4*)(Ab + 68);
            Dc[0] = (c == 0) ? 1.f : 0.f;
#pragma unroll
            for (int i = 1; i < 16; ++i) {
                if (i + 1 < 16) {
#pragma unroll
                    for (int q = 0; q <= i / 4; ++q) rb[(i + 1) & 1][q] = *(const LAS f32x4*)(Ab + (i + 1) * 68 + 4 * q);
                }
                float s0 = (i == c) ? 1.f : 0.f, s1 = 0.f;
#pragma unroll
                for (int j = 0; j < i; ++j) { if (j & 1) s1 -= rb[i & 1][j >> 2][j & 3] * Dc[j]; else s0 -= rb[i & 1][j >> 2][j & 3] * Dc[j]; }
                Dc[i] = s0 + s1;
            }
            u32x4 w0, w1;
            w0.x = pk2(Dc[0], Dc[1]); w0.y = pk2(Dc[2], Dc[3]); w0.z = pk2(Dc[4], Dc[5]); w0.w = pk2(Dc[6], Dc[7]);
            w1.x = pk2(Dc[8], Dc[9]); w1.y = pk2(Dc[10], Dc[11]); w1.z = pk2(Dc[12], Dc[13]); w1.w = pk2(Dc[14], Dc[15]);
            *(LAS u32x4*)(DmT + (16 * blk + c) * 144 + 32 * blk) = w0; *(LAS u32x4*)(DmT + (16 * blk + c) * 144 + 32 * blk + 16) = w1;
            {
                const unsigned ww[8] = {w0.x, w0.y, w0.z, w0.w, w1.x, w1.y, w1.z, w1.w};
#pragma unroll
                for (int i = 0; i < 16; i += 2) { *(LAS bf16*)(Dm + (16 * blk + i) * 144 + (16 * blk + c) * 2) = (bf16)(ww[i >> 1] & 0xffffu); *(LAS bf16*)(Dm + (16 * blk + i + 1) * 144 + (16 * blk + c) * 2) = (bf16)(ww[i >> 1] >> 16); }
            }
        }
        __syncthreads(); REOPQ;
        {
            const int o = wave >> 2, mb = (wave >> 1) & 1, nb = wave & 1;
            f32x16 acc;
#pragma unroll
            for (int x = 0; x < 16; ++x) acc[x] = 0.f;
            if (o == 0) {
#pragma unroll
                for (int s = 0; s < 4; ++s) { const bf16x8 a = ldf(Dm, mb * 32 + l31, 144, s * 32 + h32 * 16), bq = ldf(AoT, nb * 32 + l31, 144, s * 32 + h32 * 16); acc = MFMA32(a, bq, acc); }
#pragma unroll
                for (int q = 0; q < 4; ++q) { u32x2 w; w.x = pk2(acc[4 * q], acc[4 * q + 1]); w.y = pk2(acc[4 * q + 2], acc[4 * q + 3]);
                    *(LAS u32x2*)(NT + (nb * 32 + l31) * 144 + (mb * 32 + 8 * q + 4 * h32) * 2) = w; }
            } else {
#pragma unroll
                for (int s = 0; s < 4; ++s) { const bf16x8 a = ldf(AoT, nb * 32 + l31, 144, s * 32 + h32 * 16), bq = ldf(Dm, mb * 32 + l31, 144, s * 32 + h32 * 16); acc = MFMA32(a, bq, acc); }
                const int m = mb * 32 + l31;
#pragma unroll
                for (int q = 0; q < 4; ++q) {
                    const int n0 = nb * 32 + 8 * q + 4 * h32;
                    u32x2 w; w.x = pk2(acc[4 * q], acc[4 * q + 1]); w.y = pk2(acc[4 * q + 2], acc[4 * q + 3]);
                    *(LAS u32x2*)(Nm + m * 144 + n0 * 2) = w;
                    u32x2 z; z.x = pk2((m == n0 ? 1.f : 0.f) - acc[4 * q], (m == n0 + 1 ? 1.f : 0.f) - acc[4 * q + 1]); z.y = pk2((m == n0 + 2 ? 1.f : 0.f) - acc[4 * q + 2], (m == n0 + 3 ? 1.f : 0.f) - acc[4 * q + 3]);
                    *(LAS u32x2*)(INm + m * 144 + n0 * 2) = z;
                }
            }
        }
        __syncthreads(); REOPQ;
        if (wave < 4) {
            const int mb = wave >> 1, nb = wave & 1;
            f32x16 acc;
#pragma unroll
            for (int x = 0; x < 16; ++x) acc[x] = 0.f;
#pragma unroll
            for (int s = 0; s < 4; ++s) { const bf16x8 a = ldf(Nm, mb * 32 + l31, 144, s * 32 + h32 * 16), bq = ldf(NT, nb * 32 + l31, 144, s * 32 + h32 * 16); acc = MFMA32(a, bq, acc); }
            const int n = nb * 32 + l31;
#pragma unroll
            for (int q = 0; q < 4; ++q) {
                const int m0 = mb * 32 + 8 * q + 4 * h32;
                u32x2 w; w.x = pk2(acc[4 * q] + (n == m0 ? 1.f : 0.f), acc[4 * q + 1] + (n == m0 + 1 ? 1.f : 0.f)); w.y = pk2(acc[4 * q + 2] + (n == m0 + 2 ? 1.f : 0.f), acc[4 * q + 3] + (n == m0 + 3 ? 1.f : 0.f));
                *(LAS u32x2*)(ZT + n * 144 + m0 * 2) = w;
            }
        }
        __syncthreads(); REOPQ;
        if (wave < 4) {
            const int mb = wave >> 1, nb = wave & 1;
            f32x16 acc;
#pragma unroll
            for (int x = 0; x < 16; ++x) acc[x] = 0.f;
#pragma unroll
            for (int s = 0; s < 4; ++s) { const bf16x8 a = ldf(ZT, nb * 32 + l31, 144, s * 32 + h32 * 16), bq = ldf(INm, mb * 32 + l31, 144, s * 32 + h32 * 16); acc = MFMA32(a, bq, acc); }
#pragma unroll
            for (int q = 0; q < 4; ++q) { u32x2 w; w.x = pk2(acc[4 * q], acc[4 * q + 1]); w.y = pk2(acc[4 * q + 2], acc[4 * q + 3]);
                *(LAS u32x2*)(Pm + (mb * 32 + l31) * 144 + (nb * 32 + 8 * q + 4 * h32) * 2) = w; }
        }
        __syncthreads(); REOPQ;
        if (wave < 4) {
            const int ib = wave >> 1, jb = wave & 1;
            f32x16 acc;
#pragma unroll
            for (int x = 0; x < 16; ++x) acc[x] = 0.f;
#pragma unroll
            for (int s = 0; s < 4; ++s) { const bf16x8 a = ldf(DmT, jb * 32 + l31, 144, s * 32 + h32 * 16), bq = ldf(Pm, ib * 32 + l31, 144, s * 32 + h32 * 16); acc = MFMA32(a, bq, acc); }
#pragma unroll
            for (int q = 0; q < 4; ++q) { u32x2 w; w.x = pk2(acc[4 * q], acc[4 * q + 1]); w.y = pk2(acc[4 * q + 2], acc[4 * q + 3]);
                *(LAS u32x2*)(Tm + (ib * 32 + l31) * 144 + (jb * 32 + 8 * q + 4 * h32) * 2) = w; }
        }
        __syncthreads(); REOPQ;
        {
            const int ib = wave >> 2, chb = wave & 3;
            f32x16 aU, aW;
#pragma unroll
            for (int x = 0; x < 16; ++x) { aU[x] = 0.f; aW[x] = 0.f; }
#pragma unroll
            for (int s = 0; s < 4; ++s) {
                const int kc = ((2 * s + h32) ^ (chb * 2 + (l31 >> 4))) & 7;
                const bf16x8 tf = ldf(Tm, ib * 32 + l31, 144, s * 32 + h32 * 16), vf = ldf(VbT, chb * 32 + l31, 144, kc * 16), kf = ldf(KgT, chb * 32 + l31, 144, kc * 16);
                aU = MFMA32(tf, vf, aU); aW = MFMA32(kf, tf, aW);
            }
#pragma unroll
            for (int q = 0; q < 4; ++q) {
                u32x2 w; w.x = pk2(aU[4 * q], aU[4 * q + 1]); w.y = pk2(aU[4 * q + 2], aU[4 * q + 3]);
                *(LAS u32x2*)(KdT + (chb * 32 + l31) * 144 + (ib * 32 + 8 * q + 4 * h32) * 2) = w;
                u32x2 z; z.x = pk2(aW[4 * q], aW[4 * q + 1]); z.y = pk2(aW[4 * q + 2], aW[4 * q + 3]);
                *(LAS u32x2*)(Kt + (ib * 32 + l31) * 272 + (chb * 32 + 8 * q + 4 * h32) * 2) = z;
            }
        }
        __syncthreads(); REOPQ;
        {
            const int ru = tid >> 2, su = tid & 3;
            const u32x4 a0 = *(const LAS u32x4*)(KdT + ru * 144 + su * 32), a1 = *(const LAS u32x4*)(KdT + ru * 144 + su * 32 + 16);
            bf16* ud = B.UT + (size_t)item * 8192 + ru * 64 + su * 16;
            *(u32x4*)ud = a0; *(u32x4*)(ud + 8) = a1;
            const int rw = tid >> 3, sw = tid & 7;
            const u32x4 c0 = *(const LAS u32x4*)(Kt + rw * 272 + sw * 32), c1 = *(const LAS u32x4*)(Kt + rw * 272 + sw * 32 + 16);
            bf16* wd = B.W + (size_t)item * 8192 + rw * 128 + sw * 16;
            *(u32x4*)wd = c0; *(u32x4*)(wd + 8) = c1;
        }
#pragma unroll
        for (int q = 0; q < 2; ++q) {
            const unsigned u = xu + (unsigned)q, e = xgid + u * xnthr; DN_XDEC(e);
            if (u < xsteps && need) {
                u32x4 w; w.x = pk2(xa[q][0], xa[q][1]); w.y = pk2(xa[q][2], xa[q][3]); w.z = pk2(xc[q][0], xc[q][1]); w.w = pk2(xc[q][2], xc[q][3]);
                if (!ok) w = (u32x4){0u, 0u, 0u, 0u};
                *(u32x4*)(TF + ((size_t)g * 1024 + n) * UGX_LD + ck * 8) = w;
            }
        }
        xu += 2;
        __syncthreads(); REOPQ;
    }
    for (; xu < xsteps; ++xu) {
        const unsigned e = xgid + xu * xnthr; DN_XDEC(e);
        if (need) {
            const float* src = KTAB + ((size_t)g * 64 + (ok ? i - j : 0)) * 256 + h * 16 + hp0;
            const f32x4 a = *(const f32x4*)src, c = *(const f32x4*)(src + 4);
            u32x4 w; w.x = pk2(a[0], a[1]); w.y = pk2(a[2], a[3]); w.z = pk2(c[0], c[1]); w.w = pk2(c[2], c[3]);
            if (!ok) w = (u32x4){0u, 0u, 0u, 0u};
            *(u32x4*)(TF + ((size_t)g * 1024 + n) * UGX_LD + ck * 8) = w;
        }
    }
#undef DN_XDEC
#undef REOPQ
#undef DN_LOAD_RAW
}

__device__ __forceinline__ void dn_scan(LAS unsigned char* lds, const Ptrs& P, int l, const DnBufs& B, int sidx) {
    const int BID = opaque_bid(), GRD = opaque_grid(); (void)BID; (void)GRD;
    LAS unsigned char* Wt = lds;
    LAS unsigned char* QGt = Wt + 17408;
    LAS unsigned char* KdT = QGt + 17408;
    LAS unsigned char* It = KdT + 18432;
    LAS unsigned char* UTt = It + 9216;
    LAS unsigned char* ST = UTt + 18432;
    LAS unsigned char* VnT = ST + 34816;
    LAS float* osq = (LAS float*)(VnT + 18432);
    const int nb = GRD / 2;
    if (sidx < 0) return;
    const int tid = opaque_tid(), wave = __builtin_amdgcn_readfirstlane(tid >> 6), lane = tid & 63, h32 = lane >> 5, l31 = lane & 31;
    for (int bh = sidx; bh < BATCH * NH; bh += nb) {
        const int b = bh >> 2, hh = bh & 3;
        f32x16 Sacc[2];
#pragma unroll
        for (int x = 0; x < 16; ++x) { Sacc[0][x] = 0.f; Sacc[1][x] = 0.f; }
        for (int e = tid; e < 34816 / 16; e += NTHREADS) *(LAS u32x4*)(ST + e * 16) = (u32x4){0u, 0u, 0u, 0u};
        const int r8 = tid >> 3, s8 = tid & 7, r4 = tid >> 2, s4 = tid & 3;
        u32x4 pw0, pw1, pq0, pq1, pk0, pk1, pu0, pu1, pi0;
        {
            const size_t it0 = (size_t)bh * 32;
            const bf16* wsrc_ = B.W + it0 * 8192 + r8 * 128 + s8 * 16; pw0 = *(const u32x4*)wsrc_; pw1 = *(const u32x4*)(wsrc_ + 8);
            const bf16* qsrc_ = B.QG + it0 * 8192 + r8 * 128 + s8 * 16; pq0 = *(const u32x4*)qsrc_; pq1 = *(const u32x4*)(qsrc_ + 8);
            const bf16* ksrc_ = B.KDT + it0 * 8192 + r4 * 64 + s4 * 16; pk0 = *(const u32x4*)ksrc_; pk1 = *(const u32x4*)(ksrc_ + 8);
            const bf16* usrc_ = B.UT + it0 * 8192 + r4 * 64 + s4 * 16; pu0 = *(const u32x4*)usrc_; pu1 = *(const u32x4*)(usrc_ + 8);
            pi0 = *(const u32x4*)(B.INTRA + it0 * 4096 + r8 * 64 + s8 * 8);
        }
        const int ib = wave >> 2, dvb = wave & 3;
        f32x4 ngv[4];
        __builtin_amdgcn_sched_barrier(0);
        { int z0 = 0; asm volatile("" : "+s"(z0));
#pragma unroll
          for (int q = 0; q < 4; ++q) ngv[q] = *(const f32x4*)(P.dn_g + l * 128 + dvb * 32 + 8 * q + 4 * h32 + z0); }
        float eg_next = B.GLAST[(size_t)bh * 32];
        __builtin_amdgcn_sched_barrier(0);
        for (int c = 0; c < 32; ++c) {
            const size_t item = (size_t)bh * 32 + c;
            *(LAS u32x4*)(Wt + r8 * 272 + s8 * 32) = pw0; *(LAS u32x4*)(Wt + r8 * 272 + s8 * 32 + 16) = pw1;
            *(LAS u32x4*)(QGt + r8 * 272 + s8 * 32) = pq0; *(LAS u32x4*)(QGt + r8 * 272 + s8 * 32 + 16) = pq1;
            *(LAS u32x4*)(KdT + r4 * 144 + s4 * 32) = pk0; *(LAS u32x4*)(KdT + r4 * 144 + s4 * 32 + 16) = pk1;
            *(LAS u32x4*)(UTt + r4 * 144 + s4 * 32) = pu0; *(LAS u32x4*)(UTt + r4 * 144 + s4 * 32 + 16) = pu1;
            *(LAS u32x4*)(It + r8 * 144 + s8 * 16) = pi0;
            const float eg = eg_next;
            __syncthreads();
            eg_next = B.GLAST[c + 1 < 32 ? item + 1 : item];
            u32x2 zq[4];
            {
                const size_t rowz = (size_t)b * SEQ + c * 64 + ib * 32 + l31;
#pragma unroll
                for (int q = 0; q < 4; ++q) zq[q] = *(const u32x2*)(P.ZDN + rowz * 512 + hh * 128 + dvb * 32 + 8 * q + 4 * h32);
            }
            constexpr bool pf_ = true; const size_t it1 = c + 1 < 32 ? item + 1 : item;
            f32x16 oacc;
            {
                f32x16 acc;
#pragma unroll
                for (int x = 0; x < 16; ++x) { acc[x] = 0.f; oacc[x] = 0.f; }
#pragma unroll
                for (int s = 0; s < 8; ++s) {
                    const bf16x8 a = ldf(Wt, ib * 32 + l31, 272, s * 32 + h32 * 16), bq = ldf(ST, dvb * 32 + l31, 272, s * 32 + h32 * 16), qf = ldf(QGt, ib * 32 + l31, 272, s * 32 + h32 * 16);
                    if (pf_) {
                        if (s == 0) pw0 = *(const u32x4*)(B.W + it1 * 8192 + r8 * 128 + s8 * 16);
                        if (s == 1) pw1 = *(const u32x4*)(B.W + it1 * 8192 + r8 * 128 + s8 * 16 + 8);
                        if (s == 2) pq0 = *(const u32x4*)(B.QG + it1 * 8192 + r8 * 128 + s8 * 16);
                        if (s == 3) pq1 = *(const u32x4*)(B.QG + it1 * 8192 + r8 * 128 + s8 * 16 + 8);
                        if (s == 4) pk0 = *(const u32x4*)(B.KDT + it1 * 8192 + r4 * 64 + s4 * 16);
                        if (s == 5) pk1 = *(const u32x4*)(B.KDT + it1 * 8192 + r4 * 64 + s4 * 16 + 8);
                        if (s == 6) { pu0 = *(const u32x4*)(B.UT + it1 * 8192 + r4 * 64 + s4 * 16); pu1 = *(const u32x4*)(B.UT + it1 * 8192 + r4 * 64 + s4 * 16 + 8); }
                        if (s == 7) pi0 = *(const u32x4*)(B.INTRA + it1 * 4096 + r8 * 64 + s8 * 8);
                    }
                    acc = MFMA32(a, bq, acc); oacc = MFMA32(bq, qf, oacc);
                    __builtin_amdgcn_sched_barrier(0);
                }
                const int dv = dvb * 32 + l31;
#pragma unroll
                for (int q = 0; q < 4; ++q) {
                    const int i0 = ib * 32 + 8 * q + 4 * h32;
                    const u32x2 u = *(const LAS u32x2*)(UTt + dv * 144 + i0 * 2);
                    const float v0 = bf2f((bf16)(u.x & 0xffff)) - acc[4 * q], v1 = bf2f((bf16)(u.x >> 16)) - acc[4 * q + 1], v2 = bf2f((bf16)(u.y & 0xffff)) - acc[4 * q + 2], v3 = bf2f((bf16)(u.y >> 16)) - acc[4 * q + 3];
                    u32x2 w; w.x = pk2(v0, v1); w.y = pk2(v2, v3);
                    *(LAS u32x2*)(VnT + dv * 144 + i0 * 2) = w;
                }
            }
            __syncthreads();
            {
#pragma unroll
                for (int s = 0; s < 4; ++s) { const bf16x8 a = ldf(VnT, dvb * 32 + l31, 144, s * 32 + h32 * 16), bq = ldf(It, ib * 32 + l31, 144, s * 32 + h32 * 16); oacc = MFMA32(a, bq, oacc); }
                float ss = 0.f;
#pragma unroll
                for (int x = 0; x < 16; ++x) ss += oacc[x] * oacc[x];
                osq[(dvb * 2 + h32) * 64 + ib * 32 + l31] = ss;
            }
            {
                const int dkb = wave & 3;
#pragma unroll
                for (int t = 0; t < 2; ++t) {
#pragma unroll
                    for (int x = 0; x < 16; ++x) Sacc[t][x] *= eg;
                }
#pragma unroll
                for (int s = 0; s < 4; ++s) {
                    const bf16x8 a = ldf(KdT, dkb * 32 + l31, 144, s * 32 + h32 * 16);
                    const bf16x8 b0 = ldf(VnT, (2 * (wave >> 2)) * 32 + l31, 144, s * 32 + h32 * 16), b1 = ldf(VnT, (2 * (wave >> 2) + 1) * 32 + l31, 144, s * 32 + h32 * 16);
                    Sacc[0] = MFMA32(a, b0, Sacc[0]); Sacc[1] = MFMA32(a, b1, Sacc[1]);
                }
            }
            __syncthreads();
            {
                const int i = ib * 32 + l31;
                const float tot = ((osq[i] + osq[64 + i]) + (osq[128 + i] + osq[192 + i])) + ((osq[256 + i] + osq[320 + i]) + (osq[384 + i] + osq[448 + i]));
                const float rinv = __builtin_amdgcn_rsqf(tot * (1.f / 128.f) + EPS);
                const size_t row = (size_t)b * SEQ + c * 64 + i;
#pragma unroll
                for (int q = 0; q < 4; ++q) {
                    const int dv0 = dvb * 32 + 8 * q + 4 * h32;
                    const u32x2 z = zq[q];
                    const f32x4 ng = ngv[q];
                    const float o0 = oacc[4 * q] * rinv * ng[0] * bf2f((bf16)(z.x & 0xffff)), o1 = oacc[4 * q + 1] * rinv * ng[1] * bf2f((bf16)(z.x >> 16));
                    const float o2 = oacc[4 * q + 2] * rinv * ng[2] * bf2f((bf16)(z.y & 0xffff)), o3 = oacc[4 * q + 3] * rinv * ng[3] * bf2f((bf16)(z.y >> 16));
                    u32x2 w; w.x = pk2(o0, o1); w.y = pk2(o2, o3);
                    *(u32x2*)(P.MIXIN + row * D + hh * 128 + dv0) = w;
                }
            }
            {
                const int dkb = wave & 3;
#pragma unroll
                for (int t = 0; t < 2; ++t) {
                    const int dv = (2 * (wave >> 2) + t) * 32 + l31;
#pragma unroll
                    for (int q = 0; q < 4; ++q) {
                        u32x2 w; w.x = pk2(Sacc[t][4 * q], Sacc[t][4 * q + 1]); w.y = pk2(Sacc[t][4 * q + 2], Sacc[t][4 * q + 3]);
                        *(LAS u32x2*)(ST + dv * 272 + (dkb * 32 + 8 * q + 4 * h32) * 2) = w;
                    }
                }
            }
        }
        __syncthreads();
    }
}

#define XB_TMO      128
#define XB_XCNT(j)  (256  + 64 * (j))
#define XB_XSUB(j)  (1280 + 64 * (j))
#define XB_XGEN(j)  (2304 + 64 * (j))
#define XB_TOP      3328
#define XB_TOPGEN   3392
#define XCD_BAR_WORDS 3456
#define XB_SPIN_CAP (1u << 18)
__device__ __forceinline__ unsigned xb_ld(unsigned* p)              { return __hip_atomic_load(p, __ATOMIC_RELAXED, __HIP_MEMORY_SCOPE_AGENT); }
__device__ __forceinline__ unsigned xb_add(unsigned* p, unsigned v) { return __hip_atomic_fetch_add(p, v, __ATOMIC_RELAXED, __HIP_MEMORY_SCOPE_AGENT); }
__device__ __forceinline__ unsigned xb_xcc_id() { return (unsigned)__builtin_amdgcn_s_getreg((3 << 11) | 20) & 0xFu; }
#define XB_SPIN(cond, bar) do { unsigned _sp = 0; while (cond) { __builtin_amdgcn_s_sleep(1); \
    if ((++_sp & 255u) == 0u) { if (xb_ld(&(bar)[XB_TMO])) break; if (_sp > XB_SPIN_CAP) { atomicAdd(&(bar)[XB_TMO], 1u); break; } } } } while (0)
struct XcdBarrier { unsigned* bar; unsigned x; volatile LAS unsigned* st; };
__device__ __forceinline__ XcdBarrier xcd_barrier_post(unsigned* bar, volatile LAS unsigned* st) {
    XcdBarrier b; b.bar = bar; b.x = xb_xcc_id(); b.st = st;
    if (threadIdx.x == 0) (void)xb_add(&bar[XB_XCNT(b.x)], 1u);
    return b;
}
__device__ __forceinline__ void xcd_barrier_complete(unsigned* bar, unsigned x, unsigned& nloc, unsigned& nx) {
    const unsigned G = gridDim.x * gridDim.y * gridDim.z;
    unsigned sum, cnt, mine, sp = 0u;
    for (;;) {
        sum = 0u; cnt = 0u; mine = 0u;
#pragma unroll
        for (unsigned j = 0; j < 16; ++j) { const unsigned c = xb_ld(&bar[XB_XCNT(j)]); sum += c; cnt += (c > 0u) ? 1u : 0u; mine = (j == x) ? c : mine; }
        if (sum == G) break;
        __builtin_amdgcn_s_sleep(1);
        if ((++sp & 255u) == 0u) { if (xb_ld(&bar[XB_TMO])) break; if (sp > XB_SPIN_CAP) { atomicAdd(&bar[XB_TMO], 1u); break; } }
    }
    nloc = mine > 0u ? mine : 1u; nx = cnt > 0u ? cnt : 1u;
}
__device__ __forceinline__ void xcd_barrier(const XcdBarrier& b) {
    asm volatile("s_waitcnt vmcnt(0)" ::: "memory");
    __syncthreads();
    if (threadIdx.x == 0) {
        unsigned* bar = b.bar;
        __builtin_amdgcn_s_waitcnt(0);
        unsigned nloc = b.st[0], nx = b.st[1];
        if (nloc == 0u) { xcd_barrier_complete(bar, b.x, nloc, nx); b.st[0] = nloc; b.st[1] = nx; }
        const unsigned old = xb_add(&bar[XB_XSUB(b.x)], 1u);
        const unsigned gen = old / nloc;
        if (old + 1u == (gen + 1u) * nloc) {
            __builtin_amdgcn_fence(__ATOMIC_RELEASE, "agent");
            asm volatile("s_waitcnt vmcnt(0)" ::: "memory");
            const unsigned og = xb_add(&bar[XB_TOP], 1u);
            const unsigned tg = og / nx;
            if (og + 1u == (tg + 1u) * nx) xb_add(&bar[XB_TOPGEN], 1u);
            else XB_SPIN(xb_ld(&bar[XB_TOPGEN]) == tg, bar);
            __builtin_amdgcn_fence(__ATOMIC_ACQUIRE, "agent");
            xb_add(&bar[XB_XGEN(b.x)], 1u);
            asm volatile("s_waitcnt vmcnt(0)" ::: "memory");
        } else {
            XB_SPIN(xb_ld(&bar[XB_XGEN(b.x)]) == gen, bar);
            __builtin_amdgcn_fence(__ATOMIC_ACQUIRE, "agent");
            asm volatile("s_waitcnt vmcnt(0)" ::: "memory");
        }
    }
    __syncthreads();
}

typedef const __attribute__((address_space(4))) Args* KArgs;
#define MKP const int BID = opaque_bid(), GRD = opaque_grid(); (void)BID; (void)GRD; Ptrs P; unsigned char* ws; { KArgs ap = (KArgs)__builtin_amdgcn_kernarg_segment_ptr(); asm volatile("" : "+s"(ap)); \
    P.x = ap->in[0]; P.pre_g = ap->in[1]; P.post_g = ap->in[2]; P.w_in = ap->in[3]; P.conv_w = ap->in[4]; P.a_log = ap->in[5]; P.dt_bias = ap->in[6]; P.dn_g = ap->in[7]; \
    P.a_re = ap->in[8]; P.a_im = ap->in[9]; P.b_re = ap->in[10]; P.b_im = ap->in[11]; P.c_re = ap->in[12]; P.c_im = ap->in[13]; P.sd = ap->in[14]; P.log_dt = ap->in[15]; \
    P.glu_w = ap->in[16]; P.glu_b = ap->in[17]; P.w_out = ap->in[18]; P.out = ap->out; ws = ap->ws; \
    P.XN = (bf16*)(ws + WS_XN); P.MIXIN = P.XN; P.QKVR = (bf16*)(ws + WS_QKV); P.MIXO = (bf16*)(ws + WS_MIXO); P.YS = (bf16*)(ws + WS_YS); \
    P.ZDN = (bf16*)(ws + WS_ZDN); P.ZS = (bf16*)(ws + WS_ZS); P.UGX = (bf16*)(ws + WS_UGX); \
    P.BETA = (float*)(ws + WS_BETA); P.GLOG = (float*)(ws + WS_GLOG); P.SSQ = (float*)(ws + WS_SSQ); } \
    const DnBufs DB{(bf16*)(ws + WS_DNUT), (bf16*)(ws + WS_DNW), (bf16*)(ws + WS_DNQG), (bf16*)(ws + WS_DNKD), (bf16*)(ws + WS_DNIN), (float*)(ws + WS_GLAST)}; \
    bf16* const TF = (bf16*)(ws + WS_TF); bf16* const WE = (bf16*)(ws + WS_WE); float* const EST = (float*)(ws + WS_EST); float* const KTAB = (float*)(ws + WS_KTAB); (void)DB; (void)TF; (void)WE; (void)EST; (void)KTAB;
#define KARG() ({ KArgs ap_ = (KArgs)__builtin_amdgcn_kernarg_segment_ptr(); asm volatile("" : "+s"(ap_)); ap_; })
#define IN(k) ({ KArgs q_ = KARG(); q_->lo <= (k) && (k) < q_->hi; })
#define SEAM(k) do { if (IN(k) && IN((k) + 1)) { { KArgs q2_ = KARG(); XcdBarrier xb_; xb_.bar = (unsigned*)(q2_->ws + WS_CTL) + 1024; xb_.x = xb_xcc_id(); \
        xb_.st = (volatile LAS unsigned*)((LAS unsigned char*)lds + MISC_OFF) + 8; xcd_barrier(xb_); } } } while (0)
template <int l>
__device__ __forceinline__ void layer_phases(unsigned char* lds, cg::grid_group& grid) {
        for (int rep_ = 0; rep_ < (PROBE_REP == 0 ? 2 : 1); ++rep_) if (IN(NPH * l + 0)) {
            MKP
            if (l == 0) { prologue_weights((LAS unsigned char*)lds, P, ws); p0_norm((LAS unsigned char*)lds, P, 0, 0, P.x, nullptr, nullptr, P.pre_g); }
            else p0_norm((LAS unsigned char*)lds, P, l, 1, l == 1 ? P.x : P.out, P.out, P.post_g + (l - 1) * D, P.pre_g + l * D);
#if FAST_S5
            s5_build((LAS unsigned char*)lds, P, l, TF, WE, KTAB);
#endif
        }
        SEAM(NPH * l + 0);
        for (int rep_ = 0; rep_ < (PROBE_REP == 1 ? 2 : 1); ++rep_) if (IN(NPH * l + 1)) {
            MKP
#if FAST_P1
            pg8::Gemm g{P.XN, (const bf16*)(ws + WS_WIN) + (size_t)l * 3072 * D, D, D, D, 1 << 20};
            pg8::StaticOrder S; S.init(T, 3072, GRD, BID);
            EpiInProj E{P.QKVR, P.ZDN, P.ZS, P.UGX, P.BETA, P.GLOG, P.a_log + l * 4, P.dt_bias + l * 4};
            pg8::gemm_phase<EpiInProj, pg8::StaticOrder>((LAS unsigned char*)lds, g, S, E);
#else
            ngemm<0>(lds, P, l, P.XN, D, P.w_in + (size_t)l * D * INC, INC, INC, D);
#endif
        }
        SEAM(NPH * l + 1);
        for (int rep_ = 0; rep_ < (PROBE_REP == 2 ? 2 : 1); ++rep_) if (IN(NPH * l + 2)) {
            MKP
#if FAST_DN
            dn_chunk((LAS unsigned char*)lds, P, l, DB, TF, KTAB);
#endif
        }
        SEAM(NPH * l + 2);
        for (int rep_ = 0; rep_ < (PROBE_REP == 3 ? 2 : 1); ++rep_) if (IN(NPH * l + 3)) {
            MKP
#if FAST_DN
            const bool byx = (GRD & 7) == 0;
            const int rsub = (BID >> 3) * 4 + (BID & 3);
            const int sidx = byx ? (((BID & 7) < 4) ? rsub : -1) : (BID < GRD / 2 ? BID : -1);
            dn_scan((LAS unsigned char*)lds, P, l, DB, sidx);
#else
            dn_naive(lds, P, l);
#endif
#if FAST_S5
            {
                const int nb = GRD / 2, cnt = GRD - nb, c0 = byx ? (((BID & 7) >= 4) ? rsub : -1) : BID - nb;
                const int c = c0 < 0 ? c0 : (byx ? (c0 & 3) * (cnt >> 2) + (c0 >> 2) : ((cnt & 7) == 0 ? (c0 & 7) * (cnt >> 3) + (c0 >> 3) : c0));
                if (c >= 0) {
                    {
                        pg8::Gemm ge{P.UGX, WE, UGX_LD, 1024, 1024, 4};
                        S5EOrder SE{1, cnt, c};
                        EpiEst EE{EST};
                        pg8::gemm_phase<EpiEst, S5EOrder>((LAS unsigned char*)lds, ge, SE, EE);
                        asm volatile("s_waitcnt vmcnt(0)" ::: "memory");
                        __syncthreads();
                    }
                    const int tid = opaque_tid();
                    for (int pm = c; pm < NG * 4; pm += cnt) s5_carry(P, l, pm, EST, P.UGX, tid);
                    asm volatile("s_waitcnt vmcnt(0)" ::: "memory");
                    __syncthreads();
                    pg8::Gemm g{P.UGX, TF, UGX_LD, UGX_LD, UGX_LD, 4};
                    S5Order S{4, cnt, c};
                    EpiS5 E{P.YS};
                    pg8::gemm_phase<EpiS5, S5Order>((LAS unsigned char*)lds, g, S, E);
                }
            }
#else
            s5_naive(P, l);
#endif
        }
        SEAM(NPH * l + 3);
        for (int rep_ = 0; rep_ < (PROBE_REP == 4 ? 2 : 1); ++rep_) if (IN(NPH * l + 4)) {
            MKP
#if FAST_P3
            pg8::Gemm g{P.YS, (const bf16*)(ws + WS_WGLU) + (size_t)l * 1024 * SW, SW, SW, SW, 1 << 20};
            pg8::StaticOrder S; S.init(T, 1024, GRD, BID);
            EpiGlu E{P.MIXIN, P.ZS, P.glu_b + l * 1024};
            pg8::gemm_phase<EpiGlu, pg8::StaticOrder>((LAS unsigned char*)lds, g, S, E);
#else
            ngemm<1>(lds, P, l, P.YS, SW, P.glu_w + (size_t)l * SW * 1024, 1024, 512, SW);
#endif
        }
        SEAM(NPH * l + 4);
        for (int rep_ = 0; rep_ < (PROBE_REP == 5 ? 2 : 1); ++rep_) if (IN(NPH * l + 5)) {
            MKP
#if FAST_P4
            pg8::Gemm g{P.MIXIN, (const bf16*)(ws + WS_WOUT) + (size_t)l * D * D, D, D, D, 1 << 20};
            pg8::StaticOrder S; S.init(T, D, GRD, BID);
            EpiOut E{P.MIXO, P.SSQ};
            pg8::gemm_phase<EpiOut, pg8::StaticOrder>((LAS unsigned char*)lds, g, S, E);
#else
            ngemm<2>(lds, P, l, P.MIXIN, D, P.w_out + (size_t)l * D * D, D, D, D);
#endif
        }
        SEAM(NPH * l + 5);
    }

__global__ void __launch_bounds__(NTHREADS, 2) fwd(Args a) {
    extern __shared__ __attribute__((aligned(16))) unsigned char lds[];
    cg::grid_group grid = cg::this_grid();
    volatile LAS unsigned* MISC = (volatile LAS unsigned*)((LAS unsigned char*)lds + MISC_OFF);
    if (threadIdx.x < 32) MISC[threadIdx.x] = 0u;
    __syncthreads();
    (void)xcd_barrier_post((unsigned*)(a.ws + WS_CTL) + 1024, MISC + 8);
    layer_phases<0>(lds, grid);
    layer_phases<1>(lds, grid);
    static_assert(DEPTH == 2, "two explicit layer instantiations");
    if (IN(NPH * DEPTH)) { MKP p0_norm((LAS unsigned char*)lds, P, 0, 2, P.out, P.out, P.post_g + (DEPTH - 1) * D, nullptr); }
#undef IN
#undef SEAM
}

extern "C" void kernel_launch(void* const* d_in, const int* in_sizes, int n_in, void* d_out, int out_size, void* d_ws, size_t ws_size, hipStream_t stream) {
    static int grid = 0;
    if (grid == 0) {
        if (n_in != 19 || in_sizes[0] != T * D || out_size != T * D || ws_size < WS_END) {
            fprintf(stderr, "kernel_launch: unexpected shapes/workspace: n_in %d in0 %d out %d ws %zu (need %zu)\n", n_in, n_in > 0 ? in_sizes[0] : -1, out_size, ws_size, (size_t)WS_END);
            grid = -1; return;
        }
        int dev = 0, cus = 0, per_cu = 0;
        hipGetDevice(&dev);
        hipDeviceGetAttribute(&cus, hipDeviceAttributeMultiprocessorCount, dev);
        hipFuncSetAttribute((const void*)fwd, hipFuncAttributeMaxDynamicSharedMemorySize, LDS_BYTES);
        hipOccupancyMaxActiveBlocksPerMultiprocessor(&per_cu, (const void*)fwd, NTHREADS, LDS_BYTES);
        if (per_cu < 1) { fprintf(stderr, "kernel_launch: occupancy query says %d blocks/CU\n", per_cu); per_cu = 1; }
        (void)hipGetLastError();
        grid = cus;
        fprintf(stderr, "kernel_launch: cus %d per_cu %d grid %d ws %zu\n", cus, per_cu, grid, ws_size);
    }
    if (grid < 0) return;
    if (hipMemsetAsync((char*)d_ws + WS_CTL, 0, CTL_ZERO_BYTES, stream) != hipSuccess) { fprintf(stderr, "kernel_launch: memset failed\n"); return; }
    Args a{};
    for (int i = 0; i < 19; ++i) a.in[i] = (const float*)d_in[i];
    a.out = (float*)d_out; a.ws = (unsigned char*)d_ws; a.lo = 0; a.hi = NPH * DEPTH + 1;
    void* args[] = {&a};
    hipError_t e = hipLaunchCooperativeKernel((const void*)fwd, dim3(grid), dim3(NTHREADS), args, LDS_BYTES, stream);
    if (e != hipSuccess) fprintf(stderr, "cooperative launch failed: %s (grid %d)\n", hipGetErrorString(e), grid);
}
```

```cpp
#include <hip/hip_runtime.h>
#include <hip/hip_cooperative_groups.h>
#include <cstdio>
#include <cstdint>
namespace cg = cooperative_groups;
#ifndef PROBE_REP
#define PROBE_REP -1
#endif
#ifndef FAST_P1
#define FAST_P1 1
#endif
#ifndef FAST_P3
#define FAST_P3 1
#endif
#ifndef FAST_P4
#define FAST_P4 1
#endif
#ifndef FAST_S5
#define FAST_S5 1
#endif
#ifndef FAST_DN
#define FAST_DN 1
#endif

constexpr int D = 1024, BATCH = 32, SEQ = 2048, DEPTH = 2, T = BATCH * SEQ;
constexpr int NH = 4, HD = 128, DNW = 512, QKV = 1536;
constexpr int NG = 32, SGC = 16, SP = 64, SW = 512;
constexpr int INC = 3080;
constexpr int C_ZDN = 1536, C_BETA = 2048, C_ALPHA = 2052, C_U = 2056, C_ZS = 2568;
constexpr float EPS = 1e-6f;
constexpr int NTHREADS = 512, NWAVES = 8;
constexpr int LDS_BYTES = 155648;
constexpr int NPH = 6;
constexpr int MISC_OFF = 153600;
constexpr size_t CTL_ZERO_BYTES = 65536;

typedef unsigned short bf16;
typedef float f32x4 __attribute__((ext_vector_type(4)));
typedef float f32x2 __attribute__((ext_vector_type(2)));
#define LAS __attribute__((address_space(3)))
__device__ __forceinline__ float bf2f(bf16 v) { return __uint_as_float(((unsigned)v) << 16); }
typedef __bf16 bf16x2_t __attribute__((ext_vector_type(2)));
__device__ __forceinline__ unsigned cvtpk(float lo, float hi) { bf16x2_t v; v[0] = (__bf16)lo; v[1] = (__bf16)hi; return __builtin_bit_cast(unsigned, v); }
__device__ __forceinline__ bf16 f2bf(float f) { return (bf16)(cvtpk(f, 0.f) & 0xffffu); }
__device__ __forceinline__ float siluf(float x) { return x * __builtin_amdgcn_rcpf(1.f + __expf(-x)); }
__device__ __forceinline__ float sigmf(float x) { return __builtin_amdgcn_rcpf(1.f + __expf(-x)); }
__device__ __forceinline__ float softplusf(float x) { return fmaxf(x, 0.f) + __logf(1.f + __expf(-fabsf(x))); }
__device__ __forceinline__ float gelu_tanh(float x) { const float u = 0.7978845608028654f * (x + 0.044715f * x * x * x); return 0.5f * x * (1.f + tanhf(u)); }
__device__ __forceinline__ int opaque_bid() { int t = blockIdx.x; asm volatile("" : "+s"(t)); return t; }
__device__ __forceinline__ int opaque_grid() { int t = gridDim.x; asm volatile("" : "+s"(t)); return t; }
__device__ __forceinline__ int opaque_tid() { int t = threadIdx.x; asm volatile("" : "+v"(t)); return t; }
#define DPPF(old_, v_, ctrl_, rmask_) __int_as_float(__builtin_amdgcn_update_dpp(__float_as_int(old_), __float_as_int(v_), (ctrl_), (rmask_), 0xF, false))
__device__ __forceinline__ float sum8_dpp(float v) {
    v += DPPF(0.f, v, 0xB1, 0xF); v += DPPF(0.f, v, 0x4E, 0xF); v += DPPF(0.f, v, 0x141, 0xF);
    return v;
}
__device__ __forceinline__ float wave_sum(float v) {
    v = sum8_dpp(v);
    v += DPPF(0.f, v, 0x140, 0xF);
    v += DPPF(0.f, v, 0x142, 0xA);
    v += DPPF(0.f, v, 0x143, 0xC);
    return __int_as_float(__builtin_amdgcn_readlane(__float_as_int(v), 63));
}
__device__ __forceinline__ float xsum32(float a, float b) { const auto r = __builtin_amdgcn_permlane32_swap(__float_as_uint(a), __float_as_uint(b), false, false); return __uint_as_float(r[0]) + __uint_as_float(r[1]); }
__device__ __forceinline__ float xsum16(float a, float b) { const auto r = __builtin_amdgcn_permlane16_swap(__float_as_uint(a), __float_as_uint(b), false, false); return __uint_as_float(r[0]) + __uint_as_float(r[1]); }
__device__ __forceinline__ float wave_scan_incl(float v) {
    v += DPPF(0.f, v, 0x111, 0xF); v += DPPF(0.f, v, 0x112, 0xF); v += DPPF(0.f, v, 0x114, 0xF); v += DPPF(0.f, v, 0x118, 0xF);
    v += DPPF(0.f, v, 0x142, 0xA); v += DPPF(0.f, v, 0x143, 0xC);
    return v;
}

constexpr size_t MiB = 1u << 20;
constexpr size_t WS_CTL = 0;
constexpr size_t WS_WIN = 2 * MiB, WS_WGLU = 16 * MiB, WS_WOUT = 18 * MiB;
constexpr size_t WS_BETA = 22 * MiB, WS_GLOG = 23 * MiB, WS_SSQ = 24 * MiB;
constexpr size_t WS_XN = 32 * MiB;
constexpr size_t WS_QKV = 160 * MiB;
constexpr size_t WS_KTAB = 29 * MiB;
constexpr size_t WS_EST = 552 * MiB, WS_TF = 568 * MiB, WS_WE = 640 * MiB;
constexpr size_t WS_DNUT = 720 * MiB, WS_DNW = 784 * MiB, WS_DNQG = 848 * MiB, WS_DNKD = 912 * MiB, WS_DNIN = 976 * MiB, WS_GLAST = 28 * MiB;
constexpr size_t WS_MIXO = 160 * MiB, WS_YS = 656 * MiB;
constexpr size_t WS_ZDN = 352 * MiB, WS_ZS = 416 * MiB;
constexpr size_t WS_UGX = 480 * MiB;
constexpr size_t WS_END = 1008 * MiB;
constexpr int UGX_LD = 1152;

struct Args { const float* in[19]; float* out; unsigned char* ws; int lo, hi; };

struct Ptrs {
    const float *x, *pre_g, *post_g, *w_in, *conv_w, *a_log, *dt_bias, *dn_g, *a_re, *a_im, *b_re, *b_im, *c_re, *c_im, *sd, *log_dt, *glu_w, *glu_b, *w_out;
    float* out;
    bf16 *XN, *MIXIN, *QKVR, *MIXO, *YS, *ZDN, *ZS, *UGX;
    float *BETA, *GLOG, *SSQ;
};

__device__ __forceinline__ void p0_norm(LAS unsigned char* lds, const Ptrs& P, int l, int mode, const float* xsrc, float* xdst, const float* postg, const float* preg) {
    const int BID = opaque_bid(), GRD = opaque_grid(); (void)BID; (void)GRD;
    const int tid_ = opaque_tid(); const int lane = tid_ & 63, wave = tid_ >> 6;
    const int gw = BID * NWAVES + wave, ngw = GRD * NWAVES;
    LAS float* W8 = (LAS float*)lds;
    float alv = 0.f, dbv = 0.f;
    const int cidx = lane >> 3;
    if (mode != 2) {
        __syncthreads();
        for (int e = tid_; e < 8 * 1024; e += NTHREADS) { const int k = e >> 3, c = e & 7; W8[c * 1024 + k] = P.w_in[(size_t)l * D * INC + (size_t)k * INC + C_BETA + c]; }
        __syncthreads();
        if (cidx >= 4) { alv = P.a_log[l * 4 + cidx - 4]; dbv = P.dt_bias[l * 4 + cidx - 4]; }
    }
    struct RowSet { float4 x[4]; uint2 mx[4]; float ss; };
    RowSet SA, SB;
#define P0_LDX(row_, j_, dst_) do { if (mode == 2) { const uint2 t_ = ((const uint2*)(xsrc + (size_t)(row_) * D))[lane + 64 * (j_)]; \
        dst_ = make_float4(__uint_as_float(t_.x), __uint_as_float(t_.y), 0.f, 0.f); } \
        else { const f32x4 t4_ = __builtin_nontemporal_load((const f32x4*)(xsrc + (size_t)(row_) * D) + lane + 64 * (j_)); dst_ = make_float4(t4_[0], t4_[1], t4_[2], t4_[3]); } } while (0)
    LAS float* const Gpo = (LAS float*)lds + 8 * 1024; LAS float* const Gpr = Gpo + 1024;
    { if (mode == 2) __syncthreads();
      for (int e = tid_; e < 1024; e += NTHREADS) { Gpo[e] = mode != 0 ? postg[e] : 0.f; Gpr[e] = mode != 2 ? preg[e] : 0.f; }
      __syncthreads(); }
    auto row_load = [&](RowSet& S, const int r) __attribute__((always_inline)) {
#pragma unroll
        for (int j = 0; j < 4; ++j) P0_LDX(r, j, S.x[j]);
        if (mode != 0) {
            S.ss = P.SSQ[(size_t)r * 16 + (lane & 15)];
            const uint2* mr = (const uint2*)(P.MIXO + (size_t)r * D) + lane;
#pragma unroll
            for (int j = 0; j < 4; ++j) { const unsigned long long t8_ = __builtin_nontemporal_load((const unsigned long long*)(mr + 64 * j)); S.mx[j] = make_uint2((unsigned)t8_, (unsigned)(t8_ >> 32)); }
        } else { S.ss = 0.f;
#pragma unroll
            for (int j = 0; j < 4; ++j) S.mx[j] = make_uint2(0u, 0u); }
    };
    auto row_step = [&](RowSet& S, const int m, const int mnext) __attribute__((always_inline)) {
        float4 v[4]; uint2 mw[4]; float ss = S.ss;
#pragma unroll
        for (int j = 0; j < 4; ++j) { mw[j] = S.mx[j];
            if (mode == 2) { const unsigned a_ = __float_as_uint(S.x[j].x), b_ = __float_as_uint(S.x[j].y);
                v[j] = make_float4(bf2f((bf16)(a_ & 0xffff)), bf2f((bf16)(a_ >> 16)), bf2f((bf16)(b_ & 0xffff)), bf2f((bf16)(b_ >> 16))); }
            else v[j] = S.x[j]; }
        unsigned lb_ = 4u * (unsigned)lane; asm volatile("" : "+v"(lb_));
        LAS float* const Wl = (LAS float*)lds + lb_;
        if (mode != 0) {
            ss = wave_sum(lane < 16 ? ss : 0.f);
            f32x2 rq; rq[0] = __builtin_amdgcn_rsqf(ss * (1.f / D) + EPS); rq[1] = rq[0]; asm volatile("" : "+v"(rq));
#pragma unroll
            for (int j = 0; j < 4; ++j) {
                const uint2 w = mw[j];
                const f32x4 g4_ = *(const LAS f32x4*)(Wl + 8 * 1024 + 256 * j); const float4 g = make_float4(g4_[0], g4_[1], g4_[2], g4_[3]);
                v[j].x += bf2f((bf16)(w.x & 0xffff)) * rq[0] * g.x; v[j].y += bf2f((bf16)(w.x >> 16)) * rq[1] * g.y;
                v[j].z += bf2f((bf16)(w.y & 0xffff)) * rq[0] * g.z; v[j].w += bf2f((bf16)(w.y >> 16)) * rq[1] * g.w;
            }
            if (mode == 2) {
                f32x4* xo = (f32x4*)(xdst + (size_t)m * D) + lane;
#pragma unroll
                for (int j = 0; j < 4; ++j) __builtin_nontemporal_store((f32x4){v[j].x, v[j].y, v[j].z, v[j].w}, xo + 64 * j);
            } else {
                uint2* xo = (uint2*)(xdst + (size_t)m * D) + lane;
#pragma unroll
                for (int j = 0; j < 4; ++j) { uint2 w; w.x = cvtpk(v[j].x, v[j].y); w.y = cvtpk(v[j].z, v[j].w); __builtin_nontemporal_store((unsigned long long)w.x | ((unsigned long long)w.y << 32), (unsigned long long*)(xo + 64 * j));
                    v[j] = make_float4(bf2f((bf16)(w.x & 0xffff)), bf2f((bf16)(w.x >> 16)), bf2f((bf16)(w.y & 0xffff)), bf2f((bf16)(w.y >> 16))); }
            }
        }
        if (mode != 2) {
            float s = 0.f;
#pragma unroll
            for (int j = 0; j < 4; ++j) s += v[j].x * v[j].x + v[j].y * v[j].y + v[j].z * v[j].z + v[j].w * v[j].w;
            s = wave_sum(s);
            f32x2 rp; rp[0] = __builtin_amdgcn_rsqf(s * (1.f / D) + EPS); rp[1] = rp[0]; asm volatile("" : "+v"(rp));
            uint2* xo = (uint2*)(P.XN + (size_t)m * D) + lane;
            float dot[8];
#pragma unroll
            for (int c = 0; c < 8; ++c) dot[c] = 0.f;
#pragma unroll
            for (int j = 0; j < 4; ++j) {
                const f32x4 g4_ = *(const LAS f32x4*)(Wl + 9 * 1024 + 256 * j); const float4 g = make_float4(g4_[0], g4_[1], g4_[2], g4_[3]);
                const float h0 = v[j].x * rp[0] * g.x, h1 = v[j].y * rp[1] * g.y, h2 = v[j].z * rp[0] * g.z, h3 = v[j].w * rp[1] * g.w;
                uint2 w;
                w.x = cvtpk(h0, h1); w.y = cvtpk(h2, h3);
                xo[64 * j] = w;
#pragma unroll
                for (int c = 0; c < 8; ++c) { const f32x4 wv = *(const LAS f32x4*)(Wl + c * 1024 + 256 * j); dot[c] += h0 * wv[0] + h1 * wv[1] + h2 * wv[2] + h3 * wv[3]; }
            }
            float r4[4], r2[2], r1;
#pragma unroll
            for (int c = 0; c < 4; ++c) r4[c] = xsum32(dot[c], dot[c + 4]);
#pragma unroll
            for (int c = 0; c < 2; ++c) r2[c] = xsum16(r4[c], r4[c + 2]);
            {
                const bool hi = (lane & 8) != 0;
                const float keep = hi ? r2[1] : r2[0], send = hi ? r2[0] : r2[1]; r1 = keep + DPPF(0.f, send, 0x128, 0xF);
            }
            r1 = sum8_dpp(r1);
            {
                float* const dst = cidx < 4 ? P.BETA + (size_t)m * 4 + cidx : P.GLOG + (size_t)m * 4 + (cidx - 4);
                *dst = cidx < 4 ? sigmf(r1) : -__expf(alv) * softplusf(r1 + dbv);
            }
        }
        __builtin_amdgcn_sched_barrier(0);
        row_load(S, mnext < T ? mnext : m);
        __builtin_amdgcn_sched_barrier(0);
    };
    if (gw < T) {
        row_load(SA, gw); row_load(SB, gw + ngw < T ? gw + ngw : gw);
        int m = gw;
        if (m + ngw < T) {
            row_step(SA, m, m + 2 * ngw); row_step(SB, m + ngw, m + 3 * ngw); m += 2 * ngw;
            for (; m + ngw < T; m += 2 * ngw) { row_step(SA, m, m + 2 * ngw); row_step(SB, m + ngw, m + 3 * ngw); }
        }
        if (m < T) row_step(SA, m, m);
    }
#undef P0_LDX
}

template <int MODE>
__device__ __forceinline__ void ngemm(unsigned char* ldsb, const Ptrs& P, int l, const bf16* A, int lda, const float* W, int N, int Ncols, int K) {
    const int BID = opaque_bid(), GRD = opaque_grid(); (void)BID; (void)GRD;
    float* As = (float*)ldsb;
    float* Bs = As + 128 * 36;
    float* Bs2 = Bs + 32 * 64;
    const int tid = opaque_tid(), tx = tid & 63, ty = tid >> 6, lane = tid & 63;
    const int nct = (Ncols + 63) / 64, nrt = T / 128;
    for (int tile = BID; tile < nrt * nct; tile += GRD) {
        const int rt = tile / nct, ct = tile % nct;
        const int row0 = rt * 128, col0 = ct * 64;
        float acc[16], acc2[16];
#pragma unroll
        for (int r = 0; r < 16; ++r) { acc[r] = 0.f; acc2[r] = 0.f; }
        for (int k0 = 0; k0 < K; k0 += 32) {
            {
                const int r = tid >> 2, kq = (tid & 3) * 8;
                const uint4 v = *(const uint4*)(A + (size_t)(row0 + r) * lda + k0 + kq);
                float* d = As + r * 36 + kq;
                d[0] = bf2f((bf16)(v.x & 0xffff)); d[1] = bf2f((bf16)(v.x >> 16));
                d[2] = bf2f((bf16)(v.y & 0xffff)); d[3] = bf2f((bf16)(v.y >> 16));
                d[4] = bf2f((bf16)(v.z & 0xffff)); d[5] = bf2f((bf16)(v.z >> 16));
                d[6] = bf2f((bf16)(v.w & 0xffff)); d[7] = bf2f((bf16)(v.w >> 16));
            }
            {
                const int k = tid >> 4, c4 = (tid & 15) * 4;
#pragma unroll
                for (int j = 0; j < 4; ++j) {
                    const int col = col0 + c4 + j;
                    Bs[k * 64 + c4 + j] = col < Ncols ? W[(size_t)(k0 + k) * N + col] : 0.f;
                    if (MODE == 1) Bs2[k * 64 + c4 + j] = W[(size_t)(k0 + k) * N + col + 512];
                }
            }
            __syncthreads();
#pragma unroll 1
            for (int kk = 0; kk < 32; kk += 4) {
                const float b0 = Bs[(kk + 0) * 64 + tx], b1 = Bs[(kk + 1) * 64 + tx], b2 = Bs[(kk + 2) * 64 + tx], b3 = Bs[(kk + 3) * 64 + tx];
                float c0 = 0.f, c1 = 0.f, c2 = 0.f, c3 = 0.f;
                if (MODE == 1) { c0 = Bs2[(kk + 0) * 64 + tx]; c1 = Bs2[(kk + 1) * 64 + tx]; c2 = Bs2[(kk + 2) * 64 + tx]; c3 = Bs2[(kk + 3) * 64 + tx]; }
#pragma unroll
                for (int r = 0; r < 16; ++r) {
                    const float4 a4 = *(const float4*)(As + (ty * 16 + r) * 36 + kk);
                    acc[r] += a4.x * b0 + a4.y * b1 + a4.z * b2 + a4.w * b3;
                    if (MODE == 1) acc2[r] += a4.x * c0 + a4.y * c1 + a4.z * c2 + a4.w * c3;
                }
            }
            __syncthreads();
        }
        const int col = col0 + tx;
#pragma unroll
        for (int r = 0; r < 16; ++r) {
            const int row = row0 + ty * 16 + r;
            const float v = acc[r];
            if (MODE == 0) {
                if (col < Ncols) {
                    if (col < C_ZDN) P.QKVR[(size_t)row * QKV + col] = f2bf(v);
                    else if (col < C_BETA) P.ZDN[(size_t)row * 512 + (col - C_ZDN)] = f2bf(siluf(v));
                    else if (col < C_ALPHA) P.BETA[(size_t)row * 4 + (col - C_BETA)] = sigmf(v);
                    else if (col < C_U) { const int h = col - C_ALPHA; P.GLOG[(size_t)row * 4 + h] = -__expf(P.a_log[l * 4 + h]) * softplusf(v + P.dt_bias[l * 4 + h]); }
                    else if (col < C_ZS) { const int c = col - C_U, g = c >> 4, hh = c & 15, b = row >> 11, t = row & 2047;
                        P.UGX[((size_t)g * 1024 + b * 32 + (t >> 6)) * UGX_LD + (t & 63) * 16 + hh] = f2bf(v); }
                    else P.ZS[(size_t)row * 512 + (col - C_ZS)] = f2bf(siluf(v));
                }
            } else if (MODE == 1) {
                const float val = v + P.glu_b[l * 1024 + col], gate = acc2[r] + P.glu_b[l * 1024 + 512 + col];
                const float o = val * sigmf(gate) * bf2f(P.ZS[(size_t)row * 512 + col]);
                P.MIXIN[(size_t)row * D + 512 + col] = f2bf(o);
            } else {
                P.MIXO[(size_t)row * D + col] = f2bf(v);
                const float s = wave_sum(v * v);
                if (lane == 0) P.SSQ[(size_t)row * 16 + ct] = s;
            }
        }
    }
}

__device__ __forceinline__ void dn_naive(unsigned char* ldsb, const Ptrs& P, int l) {
    const int BID = opaque_bid(), GRD = opaque_grid(); (void)BID; (void)GRD;
    float* qs = (float*)ldsb; float* ks = qs + 128; float* vs = ks + 128; float* red = vs + 128; float* part = red + 16; float* part2 = part + 512;
    const int tid = opaque_tid(), wave = tid >> 6, lane = tid & 63;
    const int nb = GRD / 2;
    if (BID >= nb) return;
    for (int item = BID; item < BATCH * NH; item += nb) {
        const int b = item / NH, h = item % NH;
        float S[32];
#pragma unroll
        for (int i = 0; i < 32; ++i) S[i] = 0.f;
        const int dv = tid & 127, grp = tid >> 7;
        const int pid = tid >> 7, c = tid & 127;
        const int ch = (pid < 3 ? pid : 0) * 512 + h * 128 + c;
        float cw[4];
#pragma unroll
        for (int j = 0; j < 4; ++j) cw[j] = P.conv_w[(size_t)(l * 4 + j) * QKV + ch];
        const float ng = P.dn_g[l * 128 + dv];
        for (int t = 0; t < SEQ; ++t) {
            const int row = b * SEQ + t;
            float val = 0.f;
            if (tid < 384) {
                float a = 0.f;
#pragma unroll
                for (int j = 0; j < 4; ++j) { const int tt = t - 3 + j; if (tt >= 0) a += cw[j] * bf2f(P.QKVR[(size_t)(row - 3 + j) * QKV + ch]); }
                val = siluf(a);
                const float ss = wave_sum(val * val);
                if (lane == 0) red[wave] = ss;
            }
            __syncthreads();
            if (tid < 384) {
                if (pid < 2) { const float tot = red[2 * pid] + red[2 * pid + 1]; val *= __builtin_amdgcn_rsqf(tot + EPS); if (pid == 0) val *= 0.08838834764831845f; }
                (pid == 0 ? qs : (pid == 1 ? ks : vs))[c] = val;
            }
            __syncthreads();
            const float g = P.GLOG[(size_t)row * 4 + h], beta = P.BETA[(size_t)row * 4 + h];
            const float eg = __expf(g);
            float pp = 0.f;
#pragma unroll
            for (int i = 0; i < 32; ++i) { S[i] *= eg; pp += ks[grp * 32 + i] * S[i]; }
            part[grp * 128 + dv] = pp;
            __syncthreads();
            const float pred = part[dv] + part[128 + dv] + part[256 + dv] + part[384 + dv];
            const float delta = beta * (vs[dv] - pred);
            float op = 0.f;
#pragma unroll
            for (int i = 0; i < 32; ++i) { S[i] += ks[grp * 32 + i] * delta; op += qs[grp * 32 + i] * S[i]; }
            part2[grp * 128 + dv] = op;
            __syncthreads();
            float o = 0.f;
            if (tid < 128) {
                o = part2[tid] + part2[128 + tid] + part2[256 + tid] + part2[384 + tid];
                const float ss = wave_sum(o * o);
                if (lane == 0) red[8 + wave] = ss;
            }
            __syncthreads();
            if (tid < 128) {
                const float rinv = __builtin_amdgcn_rsqf((red[8] + red[9]) * (1.f / 128.f) + EPS);
                const float z = bf2f(P.ZDN[(size_t)row * 512 + h * 128 + tid]);
                P.MIXIN[(size_t)row * D + h * 128 + tid] = f2bf(o * rinv * ng * z);
            }
        }
        __syncthreads();
    }
}

__device__ __forceinline__ void s5_naive(const Ptrs& P, int l) {
    const int BID = opaque_bid(), GRD = opaque_grid(); (void)BID; (void)GRD;
    const int nb = GRD / 2;
    if (BID < nb) return;
    const int tid_ = opaque_tid(); const int lane = tid_ & 63, wave = tid_ >> 6;
    const int gw = (BID - nb) * NWAVES + wave, ngw = (GRD - nb) * NWAVES;
    for (int item = gw; item < BATCH * NG; item += ngw) {
        const int b = item / NG, g = item % NG, p = lane;
        const float dt = __expf(P.log_dt[l * NG + g]);
        const float are = P.a_re[(size_t)(l * NG + g) * SP + p], aim = P.a_im[(size_t)(l * NG + g) * SP + p];
        const float mag = __expf(are * dt), ang = aim * dt;
        float sn, cs; sincosf(ang, &sn, &cs);
        const float lr = mag * cs, li = mag * sn;
        const float den = are * are + aim * aim, nr = lr - 1.f, ni = li;
        const float cfr = (nr * are + ni * aim) / den, cfi = (ni * are - nr * aim) / den;
        float bbr[16], bbi[16], cr[16], ci[16];
#pragma unroll
        for (int hh = 0; hh < 16; ++hh) {
            const float br = P.b_re[((size_t)(l * NG + g) * SP + p) * 16 + hh], bi = P.b_im[((size_t)(l * NG + g) * SP + p) * 16 + hh];
            bbr[hh] = cfr * br - cfi * bi; bbi[hh] = cfr * bi + cfi * br;
            cr[hh] = P.c_re[((size_t)(l * NG + g) * 16 + hh) * SP + p]; ci[hh] = P.c_im[((size_t)(l * NG + g) * 16 + hh) * SP + p];
        }
        const float dd = lane < 16 ? P.sd[l * SW + g * 16 + lane] : 0.f;
        float xr = 0.f, xi = 0.f;
        for (int t = 0; t < SEQ; ++t) {
            const int row = b * SEQ + t;
            const bf16* up = P.UGX + ((size_t)g * 1024 + b * 32 + (t >> 6)) * UGX_LD + (t & 63) * 16;
            const uint4 u0 = *(const uint4*)up, u1 = *(const uint4*)(up + 8);
            float u[16];
            u[0] = bf2f((bf16)(u0.x & 0xffff)); u[1] = bf2f((bf16)(u0.x >> 16)); u[2] = bf2f((bf16)(u0.y & 0xffff)); u[3] = bf2f((bf16)(u0.y >> 16));
            u[4] = bf2f((bf16)(u0.z & 0xffff)); u[5] = bf2f((bf16)(u0.z >> 16)); u[6] = bf2f((bf16)(u0.w & 0xffff)); u[7] = bf2f((bf16)(u0.w >> 16));
            u[8] = bf2f((bf16)(u1.x & 0xffff)); u[9] = bf2f((bf16)(u1.x >> 16)); u[10] = bf2f((bf16)(u1.y & 0xffff)); u[11] = bf2f((bf16)(u1.y >> 16));
            u[12] = bf2f((bf16)(u1.z & 0xffff)); u[13] = bf2f((bf16)(u1.z >> 16)); u[14] = bf2f((bf16)(u1.w & 0xffff)); u[15] = bf2f((bf16)(u1.w >> 16));
            float bur = 0.f, bui = 0.f;
#pragma unroll
            for (int hh = 0; hh < 16; ++hh) { bur += bbr[hh] * u[hh]; bui += bbi[hh] * u[hh]; }
            const float nxr = lr * xr - li * xi + bur, nxi = lr * xi + li * xr + bui;
            xr = nxr; xi = nxi;
            float my = 0.f, myu = 0.f;
#pragma unroll
            for (int hh = 0; hh < 16; ++hh) {
                const float y = wave_sum(cr[hh] * xr - ci[hh] * xi);
                if (lane == hh) { my = y; myu = u[hh]; }
            }
            if (lane < 16) P.YS[(size_t)row * SW + g * 16 + lane] = f2bf(gelu_tanh(my + dd * myu));
        }
    }
}

#define GAS __attribute__((address_space(1)))
typedef short bf16x8 __attribute__((ext_vector_type(8)));
typedef unsigned u32x4 __attribute__((ext_vector_type(4)));
namespace pg8 {
constexpr int BM = 256, BK = 64, HALF = 128, HTB = HALF * BK * 2, STAGE_BYTES = 8 * HTB, NXCD = 8, WGM = 8;
__host__ __device__ __forceinline__ int lds_byte(int r, int c) { const int st = (r >> 4) * 2 + (c >> 5), rr = r & 15, cc = c & 31, ob = rr * 64 + cc * 2; return st * 1024 + (ob ^ (((ob >> 9) & 1) << 5)); }
__host__ __device__ __forceinline__ void stage_rc(int b, int& R, int& C) { const int st = b / 1024, sb = b % 1024, swz = sb ^ (((sb >> 9) & 1) << 5); R = (st >> 1) * 16 + swz / 64; C = (st & 1) * 32 + (swz % 64) / 2; }
__host__ __device__ __forceinline__ int perm32(int rho) { const int n = rho >> 4, i = rho & 15; return 8 * (i >> 2) + 4 * n + (i & 3); }
struct Unit { int pm, pn; };
struct Gemm { const bf16* A; const bf16* Bt; int lda, ldb, K, mg; };
struct StaticOrder {
    int nM, nN, nwg, G, c;
    __device__ void init(int M, int N, int G_, int c_) { nM = M / BM; nN = N / BM; nwg = nM * nN; G = G_; c = c_; }
    __device__ bool next(int i, Unit& u) const {
        const long L = (long)i * G + c; if (L >= nwg) return false;
        int wgid = (int)L; { const int q = nwg / NXCD, r = nwg % NXCD, xcd = wgid % NXCD, off = wgid / NXCD; wgid = (xcd < r ? xcd * (q + 1) : r * (q + 1) + (xcd - r) * q) + off; }
        const int nig = WGM * nN, gid = wgid / nig, fm = gid * WGM, gsz = (nM - fm) < WGM ? (nM - fm) : WGM;
        u.pm = fm + ((wgid % nig) % gsz); u.pn = (wgid % nig) / gsz; return true;
    }
    __device__ __forceinline__ int ntiles(const Unit&, int nt) const { return nt; }
    __device__ __forceinline__ int koff(const Unit&, int t) const { return t; }
};
__device__ __forceinline__ unsigned cvt_pk_bf16(float lo, float hi) { return cvtpk(lo, hi); }

template <class Epi, class Sched>
__device__ __forceinline__ void gemm_phase(LAS unsigned char* lds, const Gemm g, const Sched& S, const Epi& E) {
    const int tid = opaque_tid(), wid = __builtin_amdgcn_readfirstlane(tid >> 6), lane = tid & 63, wr = wid >> 2, wc = wid & 3, fr = lane & 15, fq = lane >> 4;
    const int K = g.K, nt = K / BK;
    unsigned voffA, voffB;
    { int R, C; stage_rc(tid * 16, R, C); const int Rb = (R & ~31) + perm32(R & 31); voffA = (unsigned)(R * g.lda + C) * 2u; voffB = (unsigned)(Rb * g.ldb + C) * 2u; }
    const size_t p2A = (size_t)64 * g.lda * 2, p2B = (size_t)64 * g.ldb * 2;
    const size_t kstep = (size_t)(BK * 2);
    const size_t hstepA = (size_t)HALF * g.lda * 2, hstepB = (size_t)HALF * g.ldb * 2;
    const size_t tstepA = 2 * hstepA, tstepB = 2 * hstepB;
    const unsigned ldsw = (unsigned)wid * 1024u;
    const int aoff = lds_byte(wr * 64 + fr, fq * 8), boff = lds_byte(wc * 32 + fr, fq * 8);
#define PG8_SA(b, h) (((b) * 2 + (h)) * HTB)
#define PG8_SB(b, h) ((4 + (b) * 2 + (h)) * HTB)
#define PG8_P2(v) PG8_P2_##v
#define PG8_P2_voffA p2A
#define PG8_P2_voffB p2B
#define PG8_STAGE(bufoff, gbase, voff) do { \
        __builtin_amdgcn_global_load_lds((const unsigned*)((const char*)(gbase) + (voff)), (LAS unsigned*)(lds + (bufoff) + ldsw), 16, 0, 0); \
        __builtin_amdgcn_global_load_lds((const unsigned*)((const char*)(gbase) + PG8_P2(voff) + (voff)), (LAS unsigned*)(lds + (bufoff) + ldsw + 8192), 16, 0, 0); } while (0)
#define PG8_LDA(dst, b, h) do { _Pragma("unroll") for (int m = 0; m < 4; ++m) _Pragma("unroll") for (int k = 0; k < 2; ++k) dst[m][k] = *(const LAS bf16x8*)(lds + PG8_SA(b, h) + aoff + m * 2048 + k * 1024); } while (0)
#define PG8_LDB(dst, b, h) do { _Pragma("unroll") for (int n = 0; n < 2; ++n) _Pragma("unroll") for (int k = 0; k < 2; ++k) dst[n][k] = *(const LAS bf16x8*)(lds + PG8_SB(b, h) + boff + n * 2048 + k * 1024); } while (0)
#define PG8_MMA(ai, bj, At, Bt) do { __builtin_amdgcn_s_setprio(1); _Pragma("unroll") for (int m = 0; m < 4; ++m) _Pragma("unroll") for (int n = 0; n < 2; ++n) _Pragma("unroll") for (int k = 0; k < 2; ++k) \
        acc[ai][bj][m][n] = __builtin_amdgcn_mfma_f32_16x16x32_bf16(Bt[n][k], At[m][k], acc[ai][bj][m][n], 0, 0, 0); __builtin_amdgcn_s_setprio(0); } while (0)
#define PG8_WAIT_V(n) asm volatile("s_waitcnt vmcnt(" #n ")" ::: "memory")
#define PG8_WAIT_L(n) asm volatile("s_waitcnt lgkmcnt(" #n ")" ::: "memory")
#define PG8_BAR __builtin_amdgcn_s_barrier()
#define PG8_SCHED __builtin_amdgcn_sched_barrier(0)
    Unit cur, nxt; int ui = 0;
    if (!S.next(0, cur)) return;
    int ntc = S.ntiles(cur, nt);
    f32x4 acc[2][2][4][2];
#pragma unroll
    for (int a = 0; a < 2; ++a)
#pragma unroll
        for (int b = 0; b < 2; ++b)
#pragma unroll
            for (int m = 0; m < 4; ++m)
#pragma unroll
                for (int n = 0; n < 2; ++n) acc[a][b][m][n] = (f32x4){0.f, 0.f, 0.f, 0.f};
    bf16x8 At[4][2], B0[2][2], B1[2][2];
    const char* cA = (const char*)g.A + (size_t)cur.pm * tstepA; const char* cB = (const char*)g.Bt + (size_t)((cur.pm / g.mg) * S.nN + cur.pn) * tstepB;
    PG8_STAGE(PG8_SB(0, 0), cB, voffB); PG8_STAGE(PG8_SB(0, 1), cB + hstepB, voffB); PG8_STAGE(PG8_SA(0, 0), cA, voffA); PG8_STAGE(PG8_SA(0, 1), cA + hstepA, voffA);
    if (wr == 1) PG8_BAR;
    PG8_WAIT_V(2); PG8_BAR;
    PG8_STAGE(PG8_SB(1, 0), cB + kstep, voffB); PG8_STAGE(PG8_SA(1, 0), cA + kstep, voffA); PG8_STAGE(PG8_SB(1, 1), cB + hstepB + kstep, voffB);
    PG8_WAIT_V(6); PG8_BAR;
    for (;;) {
        const bool has_next = S.next(ui + 1, nxt);
        const char* nA = has_next ? (const char*)g.A + (size_t)nxt.pm * tstepA : cA; const char* nB = has_next ? (const char*)g.Bt + (size_t)((nxt.pm / g.mg) * S.nN + nxt.pn) * tstepB : cB;
        for (int t = 0; t < ntc; t += 2) {
            const bool last = (t == ntc - 2);
            const size_t k1 = (size_t)S.koff(cur, t + 1) * kstep, k2 = (size_t)S.koff(cur, t + 2) * kstep, k3 = (size_t)S.koff(cur, t + 3) * kstep;
            const char* a1 = cA + k1;
            const char* a2 = last ? nA : cA + k2; const char* b2 = last ? nB : cB + k2;
            const char* a3 = last ? nA + kstep : cA + k3; const char* b3 = last ? nB + kstep : cB + k3;
            PG8_LDB(B0, 0, 0); PG8_LDB(B1, 0, 1); PG8_SCHED; PG8_LDA(At, 0, 0); PG8_STAGE(PG8_SA(1, 1), a1 + hstepA, voffA);
            PG8_WAIT_V(8); PG8_WAIT_L(0); PG8_BAR; PG8_MMA(0, 0, At, B0); PG8_MMA(0, 1, At, B1); PG8_BAR; PG8_SCHED;
            PG8_LDA(At, 0, 1); PG8_STAGE(PG8_SB(0, 0), b2, voffB); PG8_STAGE(PG8_SB(0, 1), b2 + hstepB, voffB); PG8_STAGE(PG8_SA(0, 0), a2, voffA);
            PG8_WAIT_V(8); PG8_WAIT_L(0); PG8_BAR; PG8_MMA(1, 0, At, B0); PG8_MMA(1, 1, At, B1); PG8_BAR; PG8_SCHED;
            PG8_LDB(B0, 1, 0); PG8_LDB(B1, 1, 1); PG8_SCHED; PG8_LDA(At, 1, 0); PG8_STAGE(PG8_SA(0, 1), a2 + hstepA, voffA);
            PG8_WAIT_V(8); PG8_WAIT_L(0); PG8_BAR; PG8_MMA(0, 0, At, B0); PG8_MMA(0, 1, At, B1); PG8_BAR; PG8_SCHED;
            PG8_LDA(At, 1, 1); PG8_STAGE(PG8_SB(1, 0), b3, voffB); PG8_STAGE(PG8_SB(1, 1), b3 + hstepB, voffB); PG8_STAGE(PG8_SA(1, 0), a3, voffA);
            PG8_WAIT_V(8); PG8_WAIT_L(0); PG8_BAR; PG8_MMA(1, 0, At, B0); PG8_MMA(1, 1, At, B1); PG8_BAR; PG8_SCHED;
        }
        if (wr == 0) PG8_BAR;
        E(acc, cur, wr, wc, fr, fq);
        if (!has_next) break;
#pragma unroll
        for (int a = 0; a < 2; ++a)
#pragma unroll
            for (int b = 0; b < 2; ++b)
#pragma unroll
                for (int m = 0; m < 4; ++m)
#pragma unroll
                    for (int n = 0; n < 2; ++n) acc[a][b][m][n] = (f32x4){0.f, 0.f, 0.f, 0.f};
        cur = nxt; cA = nA; cB = nB; ++ui; ntc = S.ntiles(cur, nt);
        if (wr == 1) PG8_BAR;
    }
    PG8_WAIT_V(0);
    PG8_BAR;
#undef PG8_SA
#undef PG8_SB
#undef PG8_STAGE
#undef PG8_LDA
#undef PG8_LDB
#undef PG8_MMA
#undef PG8_WAIT_V
#undef PG8_P2
#undef PG8_P2_voffA
#undef PG8_P2_voffB
#undef PG8_WAIT_L
#undef PG8_BAR
#undef PG8_SCHED
}
}

__device__ __forceinline__ u32x4 pack8(const f32x4 v0, const f32x4 v1) {
    u32x4 w; w.x = pg8::cvt_pk_bf16(v0[0], v0[1]); w.y = pg8::cvt_pk_bf16(v0[2], v0[3]); w.z = pg8::cvt_pk_bf16(v1[0], v1[1]); w.w = pg8::cvt_pk_bf16(v1[2], v1[3]); return w;
}
__device__ __forceinline__ f32x4 silu4(f32x4 v) { f32x4 r; r[0] = siluf(v[0]); r[1] = siluf(v[1]); r[2] = siluf(v[2]); r[3] = siluf(v[3]); return r; }
struct EpiInProj {
    static constexpr int NST = 16;
    bf16 *QKVR, *ZDN, *ZS, *UGX; float *BETA, *GLOG; const float *a_log, *dt_bias;
    __device__ __forceinline__ void operator()(const f32x4 (&acc)[2][2][4][2], const pg8::Unit& u, int wr, int wc, int fr, int fq) const {
        const int pn = u.pn, row0 = u.pm * 256 + wr * 64 + fr, cw = wc * 32 + 8 * fq;
#pragma unroll
        for (int ai = 0; ai < 2; ++ai)
#pragma unroll
            for (int m = 0; m < 4; ++m) {
                const int row = row0 + ai * 128 + m * 16;
#pragma unroll
                for (int bj = 0; bj < 2; ++bj) {
                    f32x4 v0 = acc[ai][bj][m][0], v1 = acc[ai][bj][m][1];
                    const int ct = bj * 128 + cw;
                    bf16* dst;
                    if (pn < 6) dst = QKVR + (size_t)row * QKV + pn * 256 + ct;
                    else if (pn < 8) { v0 = silu4(v0); v1 = silu4(v1); dst = ZDN + (size_t)row * 512 + (pn - 6) * 256 + ct; }
                    else if (pn < 10) { const int c = (pn - 8) * 256 + ct; dst = UGX + ((size_t)(c >> 4) * 1024 + (row >> 6)) * UGX_LD + (row & 63) * 16 + (c & 15); }
                    else { v0 = silu4(v0); v1 = silu4(v1); dst = ZS + (size_t)row * 512 + (pn - 10) * 256 + ct; }
                    *(u32x4*)dst = pack8(v0, v1);
                }
            }
    }
};
struct EpiGlu {
    static constexpr int NST = 8;
    bf16* MIXIN; const bf16* ZS; const float* glu_b;
    __device__ __forceinline__ void operator()(const f32x4 (&acc)[2][2][4][2], const pg8::Unit& u, int wr, int wc, int fr, int fq) const {
        const int row0 = u.pm * 256 + wr * 64 + fr, col = u.pn * 128 + wc * 32 + 8 * fq;
        const f32x4 bv0 = *(const f32x4*)(glu_b + col), bv1 = *(const f32x4*)(glu_b + col + 4), bg0 = *(const f32x4*)(glu_b + 512 + col), bg1 = *(const f32x4*)(glu_b + 512 + col + 4);
#pragma unroll
        for (int ai = 0; ai < 2; ++ai)
#pragma unroll
            for (int m = 0; m < 4; ++m) {
                const int row = row0 + ai * 128 + m * 16;
                const u32x4 z = *(const u32x4*)(ZS + (size_t)row * 512 + col);
                const f32x4 a0 = acc[ai][0][m][0] + bv0, a1 = acc[ai][0][m][1] + bv1, g0 = acc[ai][1][m][0] + bg0, g1 = acc[ai][1][m][1] + bg1;
                f32x4 o0, o1;
                o0[0] = a0[0] * sigmf(g0[0]) * bf2f((bf16)(z.x & 0xffff)); o0[1] = a0[1] * sigmf(g0[1]) * bf2f((bf16)(z.x >> 16));
                o0[2] = a0[2] * sigmf(g0[2]) * bf2f((bf16)(z.y & 0xffff)); o0[3] = a0[3] * sigmf(g0[3]) * bf2f((bf16)(z.y >> 16));
                o1[0] = a1[0] * sigmf(g1[0]) * bf2f((bf16)(z.z & 0xffff)); o1[1] = a1[1] * sigmf(g1[1]) * bf2f((bf16)(z.z >> 16));
                o1[2] = a1[2] * sigmf(g1[2]) * bf2f((bf16)(z.w & 0xffff)); o1[3] = a1[3] * sigmf(g1[3]) * bf2f((bf16)(z.w >> 16));
                *(u32x4*)(MIXIN + (size_t)row * D + 512 + col) = pack8(o0, o1);
            }
    }
};
struct EpiOut {
    static constexpr int NST = 24;
    bf16* MIXO; float* SSQ;
    __device__ __forceinline__ void operator()(const f32x4 (&acc)[2][2][4][2], const pg8::Unit& u, int wr, int wc, int fr, int fq) const {
        const int row0 = u.pm * 256 + wr * 64 + fr, col0 = u.pn * 256 + wc * 32 + 8 * fq;
#pragma unroll
        for (int ai = 0; ai < 2; ++ai)
#pragma unroll
            for (int m = 0; m < 4; ++m) {
                const int row = row0 + ai * 128 + m * 16;
                float s = 0.f;
#pragma unroll
                for (int bj = 0; bj < 2; ++bj) {
                    const f32x4 v0 = acc[ai][bj][m][0], v1 = acc[ai][bj][m][1];
                    s += (v0[0] * v0[0] + v0[1] * v0[1]) + (v0[2] * v0[2] + v0[3] * v0[3]) + (v1[0] * v1[0] + v1[1] * v1[1]) + (v1[2] * v1[2] + v1[3] * v1[3]);
                    *(u32x4*)(MIXO + (size_t)row * D + col0 + bj * 128) = pack8(v0, v1);
                }
                s = xsum16(s, s); s = xsum32(s, s);
                if (fq == 0) SSQ[(size_t)row * 16 + u.pn * 4 + wc] = s;
            }
    }
};

__device__ __forceinline__ unsigned pk2(float lo, float hi) { return cvtpk(lo, hi); }
template <int KIND> __device__ __forceinline__ int wsrc(int n) {
    if (KIND == 0) return n < 2048 ? n : n + 8;
    if (KIND == 1) { const int pn = n >> 8, j = n & 255; return j < 128 ? pn * 128 + j : 512 + pn * 128 + (j - 128); }
    return n;
}
template <int KIND>
__device__ __forceinline__ void transpose_item(const float* W, int K, int N, bf16* WT, LAS float* scr, int item, int nblk, int lane) {
    const int kb = item / nblk, nb = item % nblk, k0 = 64 * kb, n0 = 32 * nb;
    const int sc = wsrc<KIND>(n0 + (lane & 31));
#pragma unroll 8
    for (int i = 0; i < 32; ++i) { const int kk = 2 * i + (lane >> 5); scr[kk * 33 + (lane & 31)] = sc >= 0 ? W[(size_t)(k0 + kk) * N + sc] : 0.f; }
    asm volatile("s_waitcnt lgkmcnt(0)" ::: "memory");
    const int c = lane & 7;
#pragma unroll
    for (int j = 0; j < 4; ++j) { const int n = (lane >> 3) + 8 * j; const LAS float* s = scr + (8 * c) * 33 + n;
        u32x4 o; o.x = pk2(s[0 * 33], s[1 * 33]); o.y = pk2(s[2 * 33], s[3 * 33]); o.z = pk2(s[4 * 33], s[5 * 33]); o.w = pk2(s[6 * 33], s[7 * 33]);
        *(u32x4*)(WT + (size_t)(n0 + n) * K + k0 + 8 * c) = o; }
    asm volatile("s_waitcnt lgkmcnt(0)" ::: "memory");
}
__device__ __forceinline__ void prologue_weights(LAS unsigned char* lds, const Ptrs& P, unsigned char* ws) {
    const int BID = opaque_bid(), GRD = opaque_grid(); (void)BID; (void)GRD;
    const int tid_ = opaque_tid(); const int lane = tid_ & 63, wave = __builtin_amdgcn_readfirstlane(tid_ >> 6);
    LAS float* scr = (LAS float*)(lds + wave * 16384);
    const int gw = BID * NWAVES + wave, ngw = GRD * NWAVES;
    constexpr int I_IN = (D / 64) * (3072 / 32), I_GLU = (SW / 64) * (1024 / 32), I_OUT = (D / 64) * (D / 32);
    constexpr int PER = I_IN + I_GLU + I_OUT;
    for (int it = gw; it < DEPTH * PER; it += ngw) {
        const int l = it / PER; int r = it % PER;
        if (r < I_IN) { transpose_item<0>(P.w_in + (size_t)l * D * INC, D, INC, (bf16*)(ws + WS_WIN) + (size_t)l * 3072 * D, scr, r, 3072 / 32, lane); continue; } r -= I_IN;
        if (r < I_GLU) { transpose_item<1>(P.glu_w + (size_t)l * SW * 1024, SW, 1024, (bf16*)(ws + WS_WGLU) + (size_t)l * 1024 * SW, scr, r, 1024 / 32, lane); continue; } r -= I_GLU;
        transpose_item<2>(P.w_out + (size_t)l * D * D, D, D, (bf16*)(ws + WS_WOUT) + (size_t)l * D * D, scr, r, D / 32, lane);
    }
}

__device__ __forceinline__ float gelu_fast(float x) { return x * __builtin_amdgcn_rcpf(1.f + __expf(-1.5957691216057308f * (x + 0.044715f * x * x * x))); }
__device__ __forceinline__ void s5_lambda(const Ptrs& P, int l, int g, int p, int tau, float& lr, float& li) {
    const float dt = __expf(P.log_dt[l * NG + g]);
    const float are = P.a_re[(size_t)(l * NG + g) * SP + p], aim = P.a_im[(size_t)(l * NG + g) * SP + p];
    const float mag = __expf((float)tau * are * dt);
    const double rev = (double)tau * (double)aim * (double)dt * 0.15915494309189535;
    const float fr = (float)(rev - rint(rev));
    lr = mag * __cosf(fr * 6.283185307179586f); li = mag * __sinf(fr * 6.283185307179586f);
}
__device__ __forceinline__ void s5_build(LAS unsigned char* lds, const Ptrs& P, int l, bf16* TF, bf16* WE, float* KTAB) {
    const int BID = opaque_bid(), GRD = opaque_grid(); (void)BID; (void)GRD;
    LAS float* LTr = (LAS float*)lds;
    LAS float* LTi = LTr + 65 * 64;
    LAS float* CR = LTi + 65 * 64;
    LAS float* CI = CR + 16 * 64;
    LAS float* BBR = CI + 16 * 64;
    LAS float* BBI = BBR + 64 * 16;
    const int tid = opaque_tid();
    for (int item = BID; item < NG * 8; item += GRD) {
        const int g = item >> 3, part = item & 7;
        __syncthreads();
        for (int e = tid; e < 65 * 64; e += NTHREADS) { float lr, li; s5_lambda(P, l, g, e & 63, e >> 6, lr, li); LTr[e] = lr; LTi[e] = li; }
        if (tid < 64) {
            const int p = tid;
            const float are = P.a_re[(size_t)(l * NG + g) * SP + p], aim = P.a_im[(size_t)(l * NG + g) * SP + p];
            float lr, li; s5_lambda(P, l, g, p, 1, lr, li);
            const float den = are * are + aim * aim, nr = lr - 1.f, ni = li;
            const float cfr = (nr * are + ni * aim) / den, cfi = (ni * are - nr * aim) / den;
#pragma unroll
            for (int hh = 0; hh < 16; ++hh) {
                const float br = P.b_re[((size_t)(l * NG + g) * SP + p) * 16 + hh], bi = P.b_im[((size_t)(l * NG + g) * SP + p) * 16 + hh];
                BBR[p * 16 + hh] = cfr * br - cfi * bi; BBI[p * 16 + hh] = cfr * bi + cfi * br;
                CR[hh * 64 + p] = P.c_re[((size_t)(l * NG + g) * 16 + hh) * SP + p]; CI[hh * 64 + p] = P.c_im[((size_t)(l * NG + g) * 16 + hh) * SP + p];
            }
        }
        __syncthreads();
        for (int q = 0; q < 4; ++q) {
            const int e = tid + NTHREADS * q, tau = part * 8 + (e >> 8), h = (e >> 4) & 15, hp = e & 15;
            float s = 0.f;
#pragma unroll 8
            for (int p = 0; p < 64; ++p) {
                const float cr = CR[h * 64 + p], ci = CI[h * 64 + p], Lr = LTr[tau * 64 + p], Li = LTi[tau * 64 + p];
                s += (cr * Lr - ci * Li) * BBR[p * 16 + hp] - (cr * Li + ci * Lr) * BBI[p * 16 + hp];
            }
            if (tau == 0 && h == hp) s += P.sd[l * SW + g * 16 + h];
            KTAB[((size_t)g * 64 + tau) * 256 + h * 16 + hp] = s;
        }
        bf16* TFg = TF + (size_t)g * 1024 * UGX_LD;
        for (int e = tid; e < 128 * 16; e += NTHREADS) {
            const int rl = e >> 4, ck = e & 15, n = part * 128 + rl, i = n >> 4, h = n & 15, pp0 = ck * 8;
            float v[8];
#pragma unroll
            for (int x = 0; x < 8; ++x) {
                const int pp = pp0 + x, p = pp & 63;
                const float cr = CR[h * 64 + p], ci = CI[h * 64 + p], Lr = LTr[(i + 1) * 64 + p], Li = LTi[(i + 1) * 64 + p];
                v[x] = pp < 64 ? (cr * Lr - ci * Li) : -(cr * Li + ci * Lr);
            }
            u32x4 w; w.x = pk2(v[0], v[1]); w.y = pk2(v[2], v[3]); w.z = pk2(v[4], v[5]); w.w = pk2(v[6], v[7]);
            *(u32x4*)(TFg + (size_t)n * UGX_LD + 1024 + ck * 8) = w;
        }
        bf16* WEg = WE + (size_t)g * 256 * 1024;
        for (int e = tid; e < 16 * 128; e += NTHREADS) {
            const int rl = e >> 7, ck = e & 127, nn = part * 16 + rl, p = nn & 63, j = ck >> 1, hp0 = (ck & 1) * 8;
            const float Lr = LTr[(63 - j) * 64 + p], Li = LTi[(63 - j) * 64 + p];
            float v[8];
#pragma unroll
            for (int x = 0; x < 8; ++x) { const float br = BBR[p * 16 + hp0 + x], bi = BBI[p * 16 + hp0 + x]; v[x] = nn < 64 ? (Lr * br - Li * bi) : (Lr * bi + Li * br); }
            u32x4 w; w.x = pk2(v[0], v[1]); w.y = pk2(v[2], v[3]); w.z = pk2(v[4], v[5]); w.w = pk2(v[6], v[7]);
            *(u32x4*)(WEg + (size_t)nn * 1024 + ck * 8) = w;
        }
    }
    __syncthreads();
}
__device__ __forceinline__ void s5_expand(bf16* TF, const float* KTAB) {
    const int BID = opaque_bid(), GRD = opaque_grid();
    const int tid = opaque_tid();
    const unsigned nthr = (unsigned)GRD * NTHREADS;
    for (unsigned e0 = (unsigned)BID * NTHREADS + tid; e0 < (unsigned)NG * 1024u * 128u; e0 += 4u * nthr) {
        f32x4 a[4], c[4]; bool ok[4];
#pragma unroll
        for (int u = 0; u < 4; ++u) {
            const unsigned e = e0 + (unsigned)u * nthr;
            const int ck = e & 127, n = (e >> 7) & 1023, g = e >> 17, i = n >> 4, h = n & 15, j = ck >> 1, hp0 = (ck & 1) * 8;
            ok[u] = e < (unsigned)NG * 1024u * 128u && j <= i;
            const float* src = KTAB + ((size_t)g * 64 + (ok[u] ? i - j : 0)) * 256 + h * 16 + hp0;
            if (ok[u]) { a[u] = *(const f32x4*)src; c[u] = *(const f32x4*)(src + 4); } else { a[u] = (f32x4){0.f, 0.f, 0.f, 0.f}; c[u] = a[u]; }
        }
#pragma unroll
        for (int u = 0; u < 4; ++u) {
            const unsigned e = e0 + (unsigned)u * nthr;
            if (e < (unsigned)NG * 1024u * 128u && (int)((e & 127) >> 5) <= (int)(((e >> 7) & 1023) >> 8)) {
                const int ck = e & 127, n = (e >> 7) & 1023, g = e >> 17;
                u32x4 w; w.x = pk2(a[u][0], a[u][1]); w.y = pk2(a[u][2], a[u][3]); w.z = pk2(c[u][0], c[u][1]); w.w = pk2(c[u][2], c[u][3]);
                *(u32x4*)(TF + ((size_t)g * 1024 + n) * UGX_LD + ck * 8) = w;
            }
        }
    }
}
struct EpiEst {
    static constexpr int NST = 16;
    float* EST;
    __device__ __forceinline__ void operator()(const f32x4 (&acc)[2][2][4][2], const pg8::Unit& u, int wr, int wc, int fr, int fq) const {
        const int row0 = u.pm * 256 + wr * 64 + fr, col = wc * 32 + 8 * fq;
#pragma unroll
        for (int ai = 0; ai < 2; ++ai)
#pragma unroll
            for (int m = 0; m < 4; ++m) { float* d = EST + (size_t)(row0 + ai * 128 + m * 16) * 128 + col; *(f32x4*)d = acc[ai][0][m][0]; *(f32x4*)(d + 4) = acc[ai][0][m][1]; }
    }
};
struct S5Order {
    int nN, cnt, c;
    __device__ bool next(int i, pg8::Unit& u) const { const int pm = (i >> 2) * cnt + c; if (c < 0 || pm >= NG * 4) return false; u.pm = pm; u.pn = i & 3; return true; }
    __device__ __forceinline__ int ntiles(const pg8::Unit& u, int) const { return 4 * (u.pn + 1) + 2; }
    __device__ __forceinline__ int koff(const pg8::Unit& u, int t) const { const int km = 4 * (u.pn + 1); return t < km ? t : t + 16 - km; }
};
struct S5EOrder {
    int nN, cnt, c;
    __device__ bool next(int i, pg8::Unit& u) const { const int pm = i * cnt + c; if (c < 0 || pm >= NG * 4) return false; u.pm = pm; u.pn = 0; return true; }
    __device__ __forceinline__ int ntiles(const pg8::Unit&, int nt) const { return nt; }
    __device__ __forceinline__ int koff(const pg8::Unit&, int t) const { return t; }
};
__device__ __forceinline__ void s5_carry(const Ptrs& P, int l, int pm, const float* EST, bf16* UGX, int tid) {
    const int g = pm >> 2, bl = tid >> 6, p = tid & 63;
    float lr, li; s5_lambda(P, l, g, p, 64, lr, li);
    float xr = 0.f, xi = 0.f;
    const size_t row0 = (size_t)pm * 256 + bl * 32;
#pragma unroll 4
    for (int c = 0; c < 32; ++c) {
        const size_t row = row0 + c;
        UGX[row * UGX_LD + 1024 + p] = f2bf(xr); UGX[row * UGX_LD + 1088 + p] = f2bf(xi);
        const float er = __hip_atomic_load(EST + row * 128 + p, __ATOMIC_RELAXED, __HIP_MEMORY_SCOPE_AGENT), ei = __hip_atomic_load(EST + row * 128 + 64 + p, __ATOMIC_RELAXED, __HIP_MEMORY_SCOPE_AGENT);
        const float nr = lr * xr - li * xi + er, ni = lr * xi + li * xr + ei;
        xr = nr; xi = ni;
    }
}
struct EpiS5 {
    static constexpr int NST = 16;
    bf16* YS;
    __device__ __forceinline__ void operator()(const f32x4 (&acc)[2][2][4][2], const pg8::Unit& u, int wr, int wc, int fr, int fq) const {
        const int g = u.pm >> 2, rg0 = (u.pm & 3) * 256 + wr * 64 + fr;
#pragma unroll
        for (int ai = 0; ai < 2; ++ai)
#pragma unroll
            for (int m = 0; m < 4; ++m) {
                const int rg = rg0 + ai * 128 + m * 16;
                const size_t tok0 = (size_t)(rg >> 5) * SEQ + (rg & 31) * 64;
#pragma unroll
                for (int bj = 0; bj < 2; ++bj) {
                    const int col = u.pn * 256 + bj * 128 + wc * 32 + 8 * fq, i = col >> 4, h0 = col & 15;
                    f32x4 v0 = acc[ai][bj][m][0], v1 = acc[ai][bj][m][1];
#pragma unroll
                    for (int x = 0; x < 4; ++x) { v0[x] = gelu_fast(v0[x]); v1[x] = gelu_fast(v1[x]); }
                    *(u32x4*)(YS + (tok0 + i) * SW + g * 16 + h0) = pack8(v0, v1);
                }
            }
    }
};

typedef float f32x16 __attribute__((ext_vector_type(16)));
typedef unsigned u32x2 __attribute__((ext_vector_type(2)));
#define MFMA32(a, b, c) __builtin_amdgcn_mfma_f32_32x32x16_bf16((a), (b), (c), 0, 0, 0)
__device__ __forceinline__ bf16x8 ldf(const LAS unsigned char* base, int row, int ldb, int kb) { return *(const LAS bf16x8*)(base + row * ldb + kb); }
__device__ __forceinline__ int crow(int reg, int h) { return (reg & 3) + 8 * (reg >> 2) + 4 * h; }
__device__ __forceinline__ void unpack8(const u32x4 v, float* d) {
    d[0] = bf2f((bf16)(v.x & 0xffff)); d[1] = bf2f((bf16)(v.x >> 16)); d[2] = bf2f((bf16)(v.y & 0xffff)); d[3] = bf2f((bf16)(v.y >> 16));
    d[4] = bf2f((bf16)(v.z & 0xffff)); d[5] = bf2f((bf16)(v.z >> 16)); d[6] = bf2f((bf16)(v.w & 0xffff)); d[7] = bf2f((bf16)(v.w >> 16));
}
struct DnBufs { bf16 *UT, *W, *QG, *KDT, *INTRA; float* GLAST; };
constexpr int NITEM = BATCH * NH * (SEQ / 64);

__device__ __forceinline__ void dn_chunk(LAS unsigned char* lds, const Ptrs& P, int l, const DnBufs& B, bf16* TF, const float* KTAB) {
    const int BID = opaque_bid(), GRD = opaque_grid(); (void)BID; (void)GRD;
    LAS unsigned char* Kt = lds;
    LAS unsigned char* Qt = Kt + 17408;
    LAS unsigned char* KgT = Qt + 17408;
    LAS unsigned char* VbT = KgT + 18432;
    LAS unsigned char* KdT = VbT + 18432;
    LAS float* Am = (LAS float*)(KdT + 18432);
    LAS unsigned char* Tm = (LAS unsigned char*)Am + 17408;
    LAS unsigned char* AoT = Tm + 9216;
    LAS unsigned char* Dm = AoT + 9216;
    LAS unsigned char* DmT = Dm + 9216;
    LAS float* gcs = (LAS float*)(DmT + 9216);
    LAS float* bts = gcs + 64;
    LAS float* cws = bts + 64;
    LAS unsigned char* const RW0 = (LAS unsigned char*)Am, * const RW1 = Tm, * const RW2 = Dm;
    LAS unsigned char* Nm = Kt, *NT = Kt + 9216, *INm = Qt, *ZT = (LAS unsigned char*)Am, *Pm = Kt;
    const int tid0 = opaque_tid(), wave = __builtin_amdgcn_readfirstlane(tid0 >> 6);
    int tid = tid0, lane = tid0 & 63, h32 = lane >> 5, l31 = lane & 31;
#define REOPQ do { tid = tid0; asm volatile("" : "+v"(tid)); lane = tid & 63; h32 = lane >> 5; l31 = lane & 31; } while (0)
    int cur_hh = -1;
    u32x4 own[3][2], hal[3][2];
#define DN_LOAD_RAW(it_) do { const int it__ = (it_); const int chunk_ = it__ & 31, bh_ = it__ >> 5, hh_ = bh_ & 3, b_ = bh_ >> 2, row0_ = b_ * SEQ + chunk_ * 64; \
        const int r_ = tid >> 3, cg_ = tid & 7; \
        _Pragma("unroll") for (int part = 0; part < 3; ++part) { \
            const bf16* src = P.QKVR + (size_t)(row0_ + r_) * QKV + part * 512 + hh_ * 128 + cg_ * 16; \
            own[part][0] = *(const u32x4*)src; own[part][1] = *(const u32x4*)(src + 8); \
            if (r_ < 3 && chunk_ != 0) { const bf16* hs = src - (size_t)3 * QKV; hal[part][0] = *(const u32x4*)hs; hal[part][1] = *(const u32x4*)(hs + 8); } } } while (0)
    if (BID < NITEM) DN_LOAD_RAW(BID);
    float g_pf = 0.f, b_pf = 0.f;
    if (BID < NITEM && wave == 0) { const int bh2 = BID >> 5, r2 = (bh2 >> 2) * SEQ + (BID & 31) * 64 + lane; g_pf = P.GLOG[(size_t)r2 * 4 + (bh2 & 3)]; b_pf = P.BETA[(size_t)r2 * 4 + (bh2 & 3)]; }
    constexpr unsigned XTOT = (unsigned)NG * 1024u * 128u;
    const unsigned xnthr = (unsigned)GRD * NTHREADS, xgid = (unsigned)BID * NTHREADS + (unsigned)tid0, xsteps = (XTOT + xnthr - 1) / xnthr;
    unsigned xu = 0;
#define DN_XDEC(e_) const int ck = (e_) & 127, n = ((e_) >> 7) & 1023, g = ((e_) >> 17) & (NG - 1), i = n >> 4, h = n & 15, j = ck >> 1, hp0 = (ck & 1) * 8; \
        const bool need = (e_) < XTOT && (ck >> 5) <= (n >> 8), ok = j <= i; (void)need; (void)ok; (void)g; (void)h; (void)hp0
    for (int item = BID; item < NITEM; item += GRD) {
        REOPQ;
        const int chunk = item & 31, bh = item >> 5, hh = bh & 3, b = bh >> 2, row0 = b * SEQ + chunk * 64;
        f32x4 xa[2], xc[2];
#pragma unroll
        for (int q = 0; q < 2; ++q) {
            const unsigned e = xgid + (xu + (unsigned)q) * xnthr; DN_XDEC(e);
            const float* src = KTAB + ((size_t)g * 64 + (ok ? i - j : 0)) * 256 + h * 16 + hp0;
            xa[q] = *(const f32x4*)src; xc[q] = *(const f32x4*)(src + 4);
        }
        if (hh != cur_hh) {
            cur_hh = hh;
            for (int e = tid; e < 3 * 4 * 128; e += NTHREADS) { const int part = e >> 9, j = (e >> 7) & 3, c = e & 127; cws[e] = P.conv_w[(size_t)(l * 4 + j) * QKV + part * 512 + hh * 128 + c]; }
        }
        if (wave == 0) {
            float g = g_pf;
            g = wave_scan_incl(g);
            gcs[lane] = g; bts[lane] = b_pf;
            if (lane == 63) B.GLAST[item] = __expf(g);
            if (item + GRD < NITEM) { const int it2 = item + GRD, bh2 = it2 >> 5, r2 = (bh2 >> 2) * SEQ + (it2 & 31) * 64 + lane; g_pf = P.GLOG[(size_t)r2 * 4 + (bh2 & 3)]; b_pf = P.BETA[(size_t)r2 * 4 + (bh2 & 3)]; }
        }
        {
            const int r_ = tid >> 3, cg_ = tid & 7;
#pragma unroll
            for (int part = 0; part < 3; ++part) {
                LAS unsigned char* rw = part == 0 ? RW0 : (part == 1 ? RW1 : RW2);
                *(LAS u32x4*)(rw + (3 + r_) * 256 + cg_ * 32) = own[part][0]; *(LAS u32x4*)(rw + (3 + r_) * 256 + cg_ * 32 + 16) = own[part][1];
                if (r_ < 3) {
                    const u32x4 z4 = (u32x4){0u, 0u, 0u, 0u};
                    *(LAS u32x4*)(rw + r_ * 256 + cg_ * 32) = chunk != 0 ? hal[part][0] : z4; *(LAS u32x4*)(rw + r_ * 256 + cg_ * 32 + 16) = chunk != 0 ? hal[part][1] : z4;
                }
            }
        }
        const int r = tid >> 3, cg = tid & 7;
        __syncthreads(); REOPQ;
        {
            const float gc_r = gcs[r], beta_r = bts[r], glast = gcs[63];
            const float eg = __expf(gc_r), ed = __expf(glast - gc_r);
#pragma unroll
            for (int part = 0; part < 3; ++part) {
                float acc[16];
#pragma unroll
                for (int c = 0; c < 16; ++c) acc[c] = 0.f;
#pragma unroll
                for (int j = 0; j < 4; ++j) {
                    const LAS unsigned char* rw = (part == 0 ? RW0 : (part == 1 ? RW1 : RW2)) + (r + j) * 256 + cg * 32;
                    float x[16]; unpack8(*(const LAS u32x4*)rw, x); unpack8(*(const LAS u32x4*)(rw + 16), x + 8);
                    const LAS float* wp = cws + (part * 4 + j) * 128 + cg * 16;
#pragma unroll
                    for (int c4 = 0; c4 < 4; ++c4) { const f32x4 w = *(const LAS f32x4*)(wp + 4 * c4);
                        acc[4 * c4] += w[0] * x[4 * c4]; acc[4 * c4 + 1] += w[1] * x[4 * c4 + 1]; acc[4 * c4 + 2] += w[2] * x[4 * c4 + 2]; acc[4 * c4 + 3] += w[3] * x[4 * c4 + 3]; }
                }
                float ss = 0.f;
#pragma unroll
                for (int c = 0; c < 16; ++c) { acc[c] = siluf(acc[c]); ss += acc[c] * acc[c]; }
                if (part < 2) {
                    ss = sum8_dpp(ss);
                    const float rinv = __builtin_amdgcn_rsqf(ss + EPS) * (part == 0 ? 0.08838834764831845f : 1.f);
#pragma unroll
                    for (int c = 0; c < 16; ++c) acc[c] *= rinv;
                }
                if (part == 0) {
                    u32x4 w0, w1;
                    w0.x = pk2(acc[0], acc[1]); w0.y = pk2(acc[2], acc[3]); w0.z = pk2(acc[4], acc[5]); w0.w = pk2(acc[6], acc[7]);
                    w1.x = pk2(acc[8], acc[9]); w1.y = pk2(acc[10], acc[11]); w1.z = pk2(acc[12], acc[13]); w1.w = pk2(acc[14], acc[15]);
                    *(LAS u32x4*)(Qt + r * 272 + cg * 32) = w0; *(LAS u32x4*)(Qt + r * 272 + cg * 32 + 16) = w1;
                    u32x4 g0, g1;
                    g0.x = pk2(acc[0] * eg, acc[1] * eg); g0.y = pk2(acc[2] * eg, acc[3] * eg); g0.z = pk2(acc[4] * eg, acc[5] * eg); g0.w = pk2(acc[6] * eg, acc[7] * eg);
                    g1.x = pk2(acc[8] * eg, acc[9] * eg); g1.y = pk2(acc[10] * eg, acc[11] * eg); g1.z = pk2(acc[12] * eg, acc[13] * eg); g1.w = pk2(acc[14] * eg, acc[15] * eg);
                    bf16* qg = B.QG + (size_t)item * 8192 + r * 128 + cg * 16;
                    *(u32x4*)qg = g0; *(u32x4*)(qg + 8) = g1;
                } else if (part == 1) {
                    u32x4 w0, w1;
                    w0.x = pk2(acc[0], acc[1]); w0.y = pk2(acc[2], acc[3]); w0.z = pk2(acc[4], acc[5]); w0.w = pk2(acc[6], acc[7]);
                    w1.x = pk2(acc[8], acc[9]); w1.y = pk2(acc[10], acc[11]); w1.z = pk2(acc[12], acc[13]); w1.w = pk2(acc[14], acc[15]);
                    *(LAS u32x4*)(Kt + r * 272 + cg * 32) = w0; *(LAS u32x4*)(Kt + r * 272 + cg * 32 + 16) = w1;
                    const float sg = beta_r * eg;
                    const int swz = (((r >> 3) ^ cg) & 7) * 16 + (r & 7) * 2;
#pragma unroll
                    for (int c = 0; c < 16; c += 2) {
                        const unsigned wg = cvtpk(acc[c] * sg, acc[c + 1] * sg), wd = cvtpk(acc[c] * ed, acc[c + 1] * ed);
                        *(LAS bf16*)(KgT + (cg * 16 + c) * 144 + swz) = (bf16)(wg & 0xffffu); *(LAS bf16*)(KgT + (cg * 16 + c + 1) * 144 + swz) = (bf16)(wg >> 16);
                        *(LAS bf16*)(KdT + (cg * 16 + c) * 144 + swz) = (bf16)(wd & 0xffffu); *(LAS bf16*)(KdT + (cg * 16 + c + 1) * 144 + swz) = (bf16)(wd >> 16);
                    }
                } else {
                    const int swz = (((r >> 3) ^ cg) & 7) * 16 + (r & 7) * 2;
#pragma unroll
                    for (int c = 0; c < 16; c += 2) { const unsigned wv = cvtpk(acc[c] * beta_r, acc[c + 1] * beta_r);
                        *(LAS bf16*)(VbT + (cg * 16 + c) * 144 + swz) = (bf16)(wv & 0xffffu); *(LAS bf16*)(VbT + (cg * 16 + c + 1) * 144 + swz) = (bf16)(wv >> 16); }
                }
            }
        }
        __builtin_amdgcn_sched_barrier(0);
        if (item + GRD < NITEM) DN_LOAD_RAW(item + GRD);
        __syncthreads(); REOPQ;
        for (int e = tid; e < 2 * 9216 / 16; e += NTHREADS) *(LAS u32x4*)(Dm + e * 16) = (u32x4){0u, 0u, 0u, 0u};
        if (wave < 4) {
            const int ti = wave >> 1, tj = wave & 1;
            f32x16 acc;
#pragma unroll
            for (int x = 0; x < 16; ++x) acc[x] = 0.f;
            if (!(ti == 0 && tj == 1)) {
#pragma unroll
                for (int s = 0; s < 8; ++s) { const bf16x8 a = ldf(Kt, ti * 32 + l31, 272, s * 32 + h32 * 16), bq = ldf(Kt, tj * 32 + l31, 272, s * 32 + h32 * 16); acc = MFMA32(a, bq, acc); }
            }
            const int j = tj * 32 + l31; const float gj = gcs[j];
#pragma unroll
            for (int q = 0; q < 4; ++q) {
                const int i0 = ti * 32 + 8 * q + 4 * h32;
                float v[4];
#pragma unroll
                for (int k = 0; k < 4; ++k) { const int i = i0 + k; const float t = bts[i] * acc[4 * q + k] * __expf(gcs[i] - gj); v[k] = (i > j) ? t : 0.f; Am[i * 68 + j] = v[k]; }
                const bool off = (i0 >> 4) > (j >> 4);
                u32x2 w; w.x = off ? pk2(v[0], v[1]) : 0u; w.y = off ? pk2(v[2], v[3]) : 0u;
                *(LAS u32x2*)(AoT + j * 144 + i0 * 2) = w;
            }
        } else {
            const int w4 = wave - 4, ib = w4 >> 1, jb = w4 & 1;
            f32x16 acc;
#pragma unroll
            for (int x = 0; x < 16; ++x) acc[x] = 0.f;
            if (!(ib == 0 && jb == 1)) {
#pragma unroll
                for (int s = 0; s < 8; ++s) { const bf16x8 a = ldf(Kt, jb * 32 + l31, 272, s * 32 + h32 * 16), bq = ldf(Qt, ib * 32 + l31, 272, s * 32 + h32 * 16); acc = MFMA32(a, bq, acc); }
            }
            const int i = ib * 32 + l31; const float gi = gcs[i];
            bf16* dst = B.INTRA + (size_t)item * 4096 + i * 64 + jb * 32;
#pragma unroll
            for (int q = 0; q < 4; ++q) {
                float v[4];
#pragma unroll
                for (int k = 0; k < 4; ++k) { const int j = jb * 32 + 8 * q + 4 * h32 + k; const float t = acc[4 * q + k] * __expf(gi - gcs[j]); v[k] = (i >= j) ? t : 0.f; }
                u32x2 w; w.x = pk2(v[0], v[1]); w.y = pk2(v[2], v[3]);
                *(u32x2*)(dst + 8 * q + 4 * h32) = w;
            }
        }
        {
            const int rr = tid >> 2, sg = tid & 3;
            const int xs = (rr >> 4) & 7;
            const u32x4 a = *(const LAS u32x4*)(KdT + rr * 144 + ((2 * sg) ^ xs) * 16), c = *(const LAS u32x4*)(KdT + rr * 144 + ((2 * sg + 1) ^ xs) * 16);
            bf16* d = B.KDT + (size_t)item * 8192 + rr * 64 + sg * 16;
            *(u32x4*)d = a; *(u32x4*)(d + 8) = c;
        }
        __syncthreads(); REOPQ;
        if (wave == 0) {
            const int blk = lane >> 4, c = lane & 15;
            const LAS float* Ab = Am + (16 * blk) * 68 + 16 * blk;
            float Dc[16];
            f32x4 rb[2][4];
            rb[1][0] = *(const LAS f32x4*)(Ab + 68);
            Dc[0] = (c == 0) ? 1.f : 0.f;
#pragma unroll
            for (int i = 1; i < 16; ++i) {
                if (i + 1 < 16) {
#pragma unroll
                    for (int q = 0; q <= i / 4; ++q) rb[(i + 1) & 1][q] = *(const LAS f32x4*)(Ab + (i + 1) * 68 + 4 * q);
                }
                float s0 = (i == c) ? 1.f : 0.f, s1 = 0.f;
#pragma unroll
                for (int j = 0; j < i; ++j) { if (j & 1) s1 -= rb[i & 1][j >> 2][j & 3] * Dc[j]; else s0 -= rb[i & 1][j >> 2][j & 3] * Dc[j]; }
                Dc[i] = s0 + s1;
            }
            u32x4 w0, w1;
            w0.x = pk2(Dc[0], Dc[1]); w0.y = pk2(Dc[2], Dc[3]); w0.z = pk2(Dc[4], Dc[5]); w0.w = pk2(Dc[6], Dc[7]);
            w1.x = pk2(Dc[8], Dc[9]); w1.y = pk2(Dc[10], Dc[11]); w1.z = pk2(Dc[12], Dc[13]); w1.w = pk2(Dc[14], Dc[15]);
            *(LAS u32x4*)(DmT + (16 * blk + c) * 144 + 32 * blk) = w0; *(LAS u32x4*)(DmT + (16 * blk + c) * 144 + 32 * blk + 16) = w1;
            {
                const unsigned ww[8] = {w0.x, w0.y, w0.z, w0.w, w1.x, w1.y, w1.z, w1.w};
#pragma unroll
                for (int i = 0; i < 16; i += 2) { *(LAS bf16*)(Dm + (16 * blk + i) * 144 + (16 * blk + c) * 2) = (bf16)(ww[i >> 1] & 0xffffu); *(LAS bf16*)(Dm + (16 * blk + i + 1) * 144 + (16 * blk + c) * 2) = (bf16)(ww[i >> 1] >> 16); }
            }
        }
        __syncthreads(); REOPQ;
        {
            const int o = wave >> 2, mb = (wave >> 1) & 1, nb = wave & 1;
            f32x16 acc;
#pragma unroll
            for (int x = 0; x < 16; ++x) acc[x] = 0.f;
            if (o == 0) {
#pragma unroll
                for (int s = 0; s < 4; ++s) { const bf16x8 a = ldf(Dm, mb * 32 + l31, 144, s * 32 + h32 * 16), bq = ldf(AoT, nb * 32 + l31, 144, s * 32 + h32 * 16); acc = MFMA32(a, bq, acc); }
#pragma unroll
                for (int q = 0; q < 4; ++q) { u32x2 w; w.x = pk2(acc[4 * q], acc[4 * q + 1]); w.y = pk2(acc[4 * q + 2], acc[4 * q + 3]);
                    *(LAS u32x2*)(NT + (nb * 32 + l31) * 144 + (mb * 32 + 8 * q + 4 * h32) * 2) = w; }
            } else {
#pragma unroll
                for (int s = 0; s < 4; ++s) { const bf16x8 a = ldf(AoT, nb * 32 + l31, 144, s * 32 + h32 * 16), bq = ldf(Dm, mb * 32 + l31, 144, s * 32 + h32 * 16); acc = MFMA32(a, bq, acc); }
                const int m = mb * 32 + l31;
#pragma unroll
                for (int q = 0; q < 4; ++q) {
                    const int n0 = nb * 32 + 8 * q + 4 * h32;
                    u32x2 w; w.x = pk2(acc[4 * q], acc[4 * q + 1]); w.y = pk2(acc[4 * q + 2], acc[4 * q + 3]);
                    *(LAS u32x2*)(Nm + m * 144 + n0 * 2) = w;
                    u32x2 z; z.x = pk2((m == n0 ? 1.f : 0.f) - acc[4 * q], (m == n0 + 1 ? 1.f : 0.f) - acc[4 * q + 1]); z.y = pk2((m == n0 + 2 ? 1.f : 0.f) - acc[4 * q + 2], (m == n0 + 3 ? 1.f : 0.f) - acc[4 * q + 3]);
                    *(LAS u32x2*)(INm + m * 144 + n0 * 2) = z;
                }
            }
        }
        __syncthreads(); REOPQ;
        if (wave < 4) {
            const int mb = wave >> 1, nb = wave & 1;
            f32x16 acc;
#pragma unroll
            for (int x = 0; x < 16; ++x) acc[x] = 0.f;
#pragma unroll
            for (int s = 0; s < 4; ++s) { const bf16x8 a = ldf(Nm, mb * 32 + l31, 144, s * 32 + h32 * 16), bq = ldf(NT, nb * 32 + l31, 144, s * 32 + h32 * 16); acc = MFMA32(a, bq, acc); }
            const int n = nb * 32 + l31;
#pragma unroll
            for (int q = 0; q < 4; ++q) {
                const int m0 = mb * 32 + 8 * q + 4 * h32;
                u32x2 w; w.x = pk2(acc[4 * q] + (n == m0 ? 1.f : 0.f), acc[4 * q + 1] + (n == m0 + 1 ? 1.f : 0.f)); w.y = pk2(acc[4 * q + 2] + (n == m0 + 2 ? 1.f : 0.f), acc[4 * q + 3] + (n == m0 + 3 ? 1.f : 0.f));
                *(LAS u32x2*)(ZT + n * 144 + m0 * 2) = w;
            }
        }
        __syncthreads(); REOPQ;
        if (wave < 4) {
            const int mb = wave >> 1, nb = wave & 1;
            f32x16 acc;
#pragma unroll
            for (int x = 0; x < 16; ++x) acc[x] = 0.f;
#pragma unroll
            for (int s = 0; s < 4; ++s) { const bf16x8 a = ldf(ZT, nb * 32 + l31, 144, s * 32 + h32 * 16), bq = ldf(INm, mb * 32 + l31, 144, s * 32 + h32 * 16); acc = MFMA32(a, bq, acc); }
#pragma unroll
            for (int q = 0; q < 4; ++q) { u32x2 w; w.x = pk2(acc[4 * q], acc[4 * q + 1]); w.y = pk2(acc[4 * q + 2], acc[4 * q + 3]);
                *(LAS u32x2*)(Pm + (mb * 32 + l31) * 144 + (nb * 32 + 8 * q + 4 * h32) * 2) = w; }
        }
        __syncthreads(); REOPQ;
        if (wave < 4) {
            const int ib = wave >> 1, jb = wave & 1;
            f32x16 acc;
#pragma unroll
            for (int x = 0; x < 16; ++x) acc[x] = 0.f;
#pragma unroll
            for (int s = 0; s < 4; ++s) { const bf16x8 a = ldf(DmT, jb * 32 + l31, 144, s * 32 + h32 * 16), bq = ldf(Pm, ib * 32 + l31, 144, s * 32 + h32 * 16); acc = MFMA32(a, bq, acc); }
#pragma unroll
            for (int q = 0; q < 4; ++q) { u32x2 w; w.x = pk2(acc[4 * q], acc[4 * q + 1]); w.y = pk2(acc[4 * q + 2], acc[4 * q + 3]);
                *(LAS u32x2*)(Tm + (ib * 32 + l31) * 144 + (jb * 32 + 8 * q + 4 * h32) * 2) = w; }
        }
        __syncthreads(); REOPQ;
        {
            const int ib = wave >> 2, chb = wave & 3;
            f32x16 aU, aW;
#pragma unroll
            for (int x = 0; x < 16; ++x) { aU[x] = 0.f; aW[x] = 0.f; }
#pragma unroll
            for (int s = 0; s < 4; ++s) {
                const int kc = ((2 * s + h32) ^ (chb * 2 + (l31 >> 4))) & 7;
                const bf16x8 tf = ldf(Tm, ib * 32 + l31, 144, s * 32 + h32 * 16), vf = ldf(VbT, chb * 32 + l31, 144, kc * 16), kf = ldf(KgT, chb * 32 + l31, 144, kc * 16);
                aU = MFMA32(tf, vf, aU); aW = MFMA32(kf, tf, aW);
            }
#pragma unroll
            for (int q = 0; q < 4; ++q) {
                u32x2 w; w.x = pk2(aU[4 * q], aU[4 * q + 1]); w.y = pk2(aU[4 * q + 2], aU[4 * q + 3]);
                *(LAS u32x2*)(KdT + (chb * 32 + l31) * 144 + (ib * 32 + 8 * q + 4 * h32) * 2) = w;
                u32x2 z; z.x = pk2(aW[4 * q], aW[4 * q + 1]); z.y = pk2(aW[4 * q + 2], aW[4 * q + 3]);
                *(LAS u32x2*)(Kt + (ib * 32 + l31) * 272 + (chb * 32 + 8 * q + 4 * h32) * 2) = z;
            }
        }
        __syncthreads(); REOPQ;
        {
            const int ru = tid >> 2, su = tid & 3;
            const u32x4 a0 = *(const LAS u32x4*)(KdT + ru * 144 + su * 32), a1 = *(const LAS u32x4*)(KdT + ru * 144 + su * 32 + 16);
            bf16* ud = B.UT + (size_t)item * 8192 + ru * 64 + su * 16;
            *(u32x4*)ud = a0; *(u32x4*)(ud + 8) = a1;
            const int rw = tid >> 3, sw = tid & 7;
            const u32x4 c0 = *(const LAS u32x4*)(Kt + rw * 272 + sw * 32), c1 = *(const LAS u32x4*)(Kt + rw * 272 + sw * 32 + 16);
            bf16* wd = B.W + (size_t)item * 8192 + rw * 128 + sw * 16;
            *(u32x4*)wd = c0; *(u32x4*)(wd + 8) = c1;
        }
#pragma unroll
        for (int q = 0; q < 2; ++q) {
            const unsigned u = xu + (unsigned)q, e = xgid + u * xnthr; DN_XDEC(e);
            if (u < xsteps && need) {
                u32x4 w; w.x = pk2(xa[q][0], xa[q][1]); w.y = pk2(xa[q][2], xa[q][3]); w.z = pk2(xc[q][0], xc[q][1]); w.w = pk2(xc[q][2], xc[q][3]);
                if (!ok) w = (u32x4){0u, 0u, 0u, 0u};
                *(u32x4*)(TF + ((size_t)g * 1024 + n) * UGX_LD + ck * 8) = w;
            }
        }
        xu += 2;
        __syncthreads(); REOPQ;
    }
    for (; xu < xsteps; ++xu) {
        const unsigned e = xgid + xu * xnthr; DN_XDEC(e);
        if (need) {
            const float* src = KTAB + ((size_t)g * 64 + (ok ? i - j : 0)) * 256 + h * 16 + hp0;
            const f32x4 a = *(const f32x4*)src, c = *(const f32x4*)(src + 4);
            u32x4 w; w.x = pk2(a[0], a[1]); w.y = pk2(a[2], a[3]); w.z = pk2(c[0], c[1]); w.w = pk2(c[2], c[3]);
            if (!ok) w = (u32x4){0u, 0u, 0u, 0u};
            *(u32x4*)(TF + ((size_t)g * 1024 + n) * UGX_LD + ck * 8) = w;
        }
    }
#undef DN_XDEC
#undef REOPQ
#undef DN_LOAD_RAW
}

__device__ __forceinline__ void dn_scan(LAS unsigned char* lds, const Ptrs& P, int l, const DnBufs& B) {
    const int BID = opaque_bid(), GRD = opaque_grid(); (void)BID; (void)GRD;
    LAS unsigned char* Wt = lds;
    LAS unsigned char* QGt = Wt + 17408;
    LAS unsigned char* KdT = QGt + 17408;
    LAS unsigned char* It = KdT + 18432;
    LAS unsigned char* UTt = It + 9216;
    LAS unsigned char* ST = UTt + 18432;
    LAS unsigned char* VnT = ST + 34816;
    LAS float* osq = (LAS float*)(VnT + 18432);
    const int nb = GRD / 2;
    if (BID >= nb) return;
    const int tid = opaque_tid(), wave = __builtin_amdgcn_readfirstlane(tid >> 6), lane = tid & 63, h32 = lane >> 5, l31 = lane & 31;
    for (int bh = BID; bh < BATCH * NH; bh += nb) {
        const int b = bh >> 2, hh = bh & 3;
        f32x16 Sacc[2];
#pragma unroll
        for (int x = 0; x < 16; ++x) { Sacc[0][x] = 0.f; Sacc[1][x] = 0.f; }
        for (int e = tid; e < 34816 / 16; e += NTHREADS) *(LAS u32x4*)(ST + e * 16) = (u32x4){0u, 0u, 0u, 0u};
        const int r8 = tid >> 3, s8 = tid & 7, r4 = tid >> 2, s4 = tid & 3;
        u32x4 pw0, pw1, pq0, pq1, pk0, pk1, pu0, pu1, pi0;
        {
            const size_t it0 = (size_t)bh * 32;
            const bf16* wsrc_ = B.W + it0 * 8192 + r8 * 128 + s8 * 16; pw0 = *(const u32x4*)wsrc_; pw1 = *(const u32x4*)(wsrc_ + 8);
            const bf16* qsrc_ = B.QG + it0 * 8192 + r8 * 128 + s8 * 16; pq0 = *(const u32x4*)qsrc_; pq1 = *(const u32x4*)(qsrc_ + 8);
            const bf16* ksrc_ = B.KDT + it0 * 8192 + r4 * 64 + s4 * 16; pk0 = *(const u32x4*)ksrc_; pk1 = *(const u32x4*)(ksrc_ + 8);
            const bf16* usrc_ = B.UT + it0 * 8192 + r4 * 64 + s4 * 16; pu0 = *(const u32x4*)usrc_; pu1 = *(const u32x4*)(usrc_ + 8);
            pi0 = *(const u32x4*)(B.INTRA + it0 * 4096 + r8 * 64 + s8 * 8);
        }
        const int ib = wave >> 2, dvb = wave & 3;
        f32x4 ngv[4];
        __builtin_amdgcn_sched_barrier(0);
        { int z0 = 0; asm volatile("" : "+s"(z0));
#pragma unroll
          for (int q = 0; q < 4; ++q) ngv[q] = *(const f32x4*)(P.dn_g + l * 128 + dvb * 32 + 8 * q + 4 * h32 + z0); }
        float eg_next = B.GLAST[(size_t)bh * 32];
        __builtin_amdgcn_sched_barrier(0);
        for (int c = 0; c < 32; ++c) {
            const size_t item = (size_t)bh * 32 + c;
            *(LAS u32x4*)(Wt + r8 * 272 + s8 * 32) = pw0; *(LAS u32x4*)(Wt + r8 * 272 + s8 * 32 + 16) = pw1;
            *(LAS u32x4*)(QGt + r8 * 272 + s8 * 32) = pq0; *(LAS u32x4*)(QGt + r8 * 272 + s8 * 32 + 16) = pq1;
            *(LAS u32x4*)(KdT + r4 * 144 + s4 * 32) = pk0; *(LAS u32x4*)(KdT + r4 * 144 + s4 * 32 + 16) = pk1;
            *(LAS u32x4*)(UTt + r4 * 144 + s4 * 32) = pu0; *(LAS u32x4*)(UTt + r4 * 144 + s4 * 32 + 16) = pu1;
            *(LAS u32x4*)(It + r8 * 144 + s8 * 16) = pi0;
            const float eg = eg_next;
            __syncthreads();
            eg_next = B.GLAST[c + 1 < 32 ? item + 1 : item];
            u32x2 zq[4];
            {
                const size_t rowz = (size_t)b * SEQ + c * 64 + ib * 32 + l31;
#pragma unroll
                for (int q = 0; q < 4; ++q) zq[q] = *(const u32x2*)(P.ZDN + rowz * 512 + hh * 128 + dvb * 32 + 8 * q + 4 * h32);
            }
            constexpr bool pf_ = true; const size_t it1 = c + 1 < 32 ? item + 1 : item;
            f32x16 oacc;
            {
                f32x16 acc;
#pragma unroll
                for (int x = 0; x < 16; ++x) { acc[x] = 0.f; oacc[x] = 0.f; }
#pragma unroll
                for (int s = 0; s < 8; ++s) {
                    const bf16x8 a = ldf(Wt, ib * 32 + l31, 272, s * 32 + h32 * 16), bq = ldf(ST, dvb * 32 + l31, 272, s * 32 + h32 * 16), qf = ldf(QGt, ib * 32 + l31, 272, s * 32 + h32 * 16);
                    if (pf_) {
                        if (s == 0) pw0 = *(const u32x4*)(B.W + it1 * 8192 + r8 * 128 + s8 * 16);
                        if (s == 1) pw1 = *(const u32x4*)(B.W + it1 * 8192 + r8 * 128 + s8 * 16 + 8);
                        if (s == 2) pq0 = *(const u32x4*)(B.QG + it1 * 8192 + r8 * 128 + s8 * 16);
                        if (s == 3) pq1 = *(const u32x4*)(B.QG + it1 * 8192 + r8 * 128 + s8 * 16 + 8);
                        if (s == 4) pk0 = *(const u32x4*)(B.KDT + it1 * 8192 + r4 * 64 + s4 * 16);
                        if (s == 5) pk1 = *(const u32x4*)(B.KDT + it1 * 8192 + r4 * 64 + s4 * 16 + 8);
                        if (s == 6) { pu0 = *(const u32x4*)(B.UT + it1 * 8192 + r4 * 64 + s4 * 16); pu1 = *(const u32x4*)(B.UT + it1 * 8192 + r4 * 64 + s4 * 16 + 8); }
                        if (s == 7) pi0 = *(const u32x4*)(B.INTRA + it1 * 4096 + r8 * 64 + s8 * 8);
                    }
                    acc = MFMA32(a, bq, acc); oacc = MFMA32(bq, qf, oacc);
                    __builtin_amdgcn_sched_barrier(0);
                }
                const int dv = dvb * 32 + l31;
#pragma unroll
                for (int q = 0; q < 4; ++q) {
                    const int i0 = ib * 32 + 8 * q + 4 * h32;
                    const u32x2 u = *(const LAS u32x2*)(UTt + dv * 144 + i0 * 2);
                    const float v0 = bf2f((bf16)(u.x & 0xffff)) - acc[4 * q], v1 = bf2f((bf16)(u.x >> 16)) - acc[4 * q + 1], v2 = bf2f((bf16)(u.y & 0xffff)) - acc[4 * q + 2], v3 = bf2f((bf16)(u.y >> 16)) - acc[4 * q + 3];
                    u32x2 w; w.x = pk2(v0, v1); w.y = pk2(v2, v3);
                    *(LAS u32x2*)(VnT + dv * 144 + i0 * 2) = w;
                }
            }
            __syncthreads();
            {
#pragma unroll
                for (int s = 0; s < 4; ++s) { const bf16x8 a = ldf(VnT, dvb * 32 + l31, 144, s * 32 + h32 * 16), bq = ldf(It, ib * 32 + l31, 144, s * 32 + h32 * 16); oacc = MFMA32(a, bq, oacc); }
                float ss = 0.f;
#pragma unroll
                for (int x = 0; x < 16; ++x) ss += oacc[x] * oacc[x];
                osq[(dvb * 2 + h32) * 64 + ib * 32 + l31] = ss;
            }
            {
                const int dkb = wave & 3;
#pragma unroll
                for (int t = 0; t < 2; ++t) {
#pragma unroll
                    for (int x = 0; x < 16; ++x) Sacc[t][x] *= eg;
                }
#pragma unroll
                for (int s = 0; s < 4; ++s) {
                    const bf16x8 a = ldf(KdT, dkb * 32 + l31, 144, s * 32 + h32 * 16);
                    const bf16x8 b0 = ldf(VnT, (2 * (wave >> 2)) * 32 + l31, 144, s * 32 + h32 * 16), b1 = ldf(VnT, (2 * (wave >> 2) + 1) * 32 + l31, 144, s * 32 + h32 * 16);
                    Sacc[0] = MFMA32(a, b0, Sacc[0]); Sacc[1] = MFMA32(a, b1, Sacc[1]);
                }
            }
            __syncthreads();
            {
                const int i = ib * 32 + l31;
                const float tot = ((osq[i] + osq[64 + i]) + (osq[128 + i] + osq[192 + i])) + ((osq[256 + i] + osq[320 + i]) + (osq[384 + i] + osq[448 + i]));
                const float rinv = __builtin_amdgcn_rsqf(tot * (1.f / 128.f) + EPS);
                const size_t row = (size_t)b * SEQ + c * 64 + i;
#pragma unroll
                for (int q = 0; q < 4; ++q) {
                    const int dv0 = dvb * 32 + 8 * q + 4 * h32;
                    const u32x2 z = zq[q];
                    const f32x4 ng = ngv[q];
                    const float o0 = oacc[4 * q] * rinv * ng[0] * bf2f((bf16)(z.x & 0xffff)), o1 = oacc[4 * q + 1] * rinv * ng[1] * bf2f((bf16)(z.x >> 16));
                    const float o2 = oacc[4 * q + 2] * rinv * ng[2] * bf2f((bf16)(z.y & 0xffff)), o3 = oacc[4 * q + 3] * rinv * ng[3] * bf2f((bf16)(z.y >> 16));
                    u32x2 w; w.x = pk2(o0, o1); w.y = pk2(o2, o3);
                    *(u32x2*)(P.MIXIN + row * D + hh * 128 + dv0) = w;
                }
            }
            {
                const int dkb = wave & 3;
#pragma unroll
                for (int t = 0; t < 2; ++t) {
                    const int dv = (2 * (wave >> 2) + t) * 32 + l31;
#pragma unroll
                    for (int q = 0; q < 4; ++q) {
                        u32x2 w; w.x = pk2(Sacc[t][4 * q], Sacc[t][4 * q + 1]); w.y = pk2(Sacc[t][4 * q + 2], Sacc[t][4 * q + 3]);
                        *(LAS u32x2*)(ST + dv * 272 + (dkb * 32 + 8 * q + 4 * h32) * 2) = w;
                    }
                }
            }
        }
        __syncthreads();
    }
}

#define XB_TMO      128
#define XB_XCNT(j)  (256  + 64 * (j))
#define XB_XSUB(j)  (1280 + 64 * (j))
#define XB_XGEN(j)  (2304 + 64 * (j))
#define XB_TOP      3328
#define XB_TOPGEN   3392
#define XCD_BAR_WORDS 3456
#define XB_SPIN_CAP (1u << 18)
__device__ __forceinline__ unsigned xb_ld(unsigned* p)              { return __hip_atomic_load(p, __ATOMIC_RELAXED, __HIP_MEMORY_SCOPE_AGENT); }
__device__ __forceinline__ unsigned xb_add(unsigned* p, unsigned v) { return __hip_atomic_fetch_add(p, v, __ATOMIC_RELAXED, __HIP_MEMORY_SCOPE_AGENT); }
__device__ __forceinline__ unsigned xb_xcc_id() { return (unsigned)__builtin_amdgcn_s_getreg((3 << 11) | 20) & 0xFu; }
#define XB_SPIN(cond, bar) do { unsigned _sp = 0; while (cond) { __builtin_amdgcn_s_sleep(1); \
    if ((++_sp & 255u) == 0u) { if (xb_ld(&(bar)[XB_TMO])) break; if (_sp > XB_SPIN_CAP) { atomicAdd(&(bar)[XB_TMO], 1u); break; } } } } while (0)
struct XcdBarrier { unsigned* bar; unsigned x; volatile LAS unsigned* st; };
__device__ __forceinline__ XcdBarrier xcd_barrier_post(unsigned* bar, volatile LAS unsigned* st) {
    XcdBarrier b; b.bar = bar; b.x = xb_xcc_id(); b.st = st;
    if (threadIdx.x == 0) (void)xb_add(&bar[XB_XCNT(b.x)], 1u);
    return b;
}
__device__ __forceinline__ void xcd_barrier_complete(unsigned* bar, unsigned x, unsigned& nloc, unsigned& nx) {
    const unsigned G = gridDim.x * gridDim.y * gridDim.z;
    unsigned sum, cnt, mine, sp = 0u;
    for (;;) {
        sum = 0u; cnt = 0u; mine = 0u;
#pragma unroll
        for (unsigned j = 0; j < 16; ++j) { const unsigned c = xb_ld(&bar[XB_XCNT(j)]); sum += c; cnt += (c > 0u) ? 1u : 0u; mine = (j == x) ? c : mine; }
        if (sum == G) break;
        __builtin_amdgcn_s_sleep(1);
        if ((++sp & 255u) == 0u) { if (xb_ld(&bar[XB_TMO])) break; if (sp > XB_SPIN_CAP) { atomicAdd(&bar[XB_TMO], 1u); break; } }
    }
    nloc = mine > 0u ? mine : 1u; nx = cnt > 0u ? cnt : 1u;
}
__device__ __forceinline__ void xcd_barrier(const XcdBarrier& b) {
    asm volatile("s_waitcnt vmcnt(0)" ::: "memory");
    __syncthreads();
    if (threadIdx.x == 0) {
        unsigned* bar = b.bar;
        __builtin_amdgcn_s_waitcnt(0);
        unsigned nloc = b.st[0], nx = b.st[1];
        if (nloc == 0u) { xcd_barrier_complete(bar, b.x, nloc, nx); b.st[0] = nloc; b.st[1] = nx; }
        const unsigned old = xb_add(&bar[XB_XSUB(b.x)], 1u);
        const unsigned gen = old / nloc;
        if (old + 1u == (gen + 1u) * nloc) {
            __builtin_amdgcn_fence(__ATOMIC_RELEASE, "agent");
            asm volatile("s_waitcnt vmcnt(0)" ::: "memory");
            const unsigned og = xb_add(&bar[XB_TOP], 1u);
            const unsigned tg = og / nx;
            if (og + 1u == (tg + 1u) * nx) xb_add(&bar[XB_TOPGEN], 1u);
            else XB_SPIN(xb_ld(&bar[XB_TOPGEN]) == tg, bar);
            __builtin_amdgcn_fence(__ATOMIC_ACQUIRE, "agent");
            xb_add(&bar[XB_XGEN(b.x)], 1u);
            asm volatile("s_waitcnt vmcnt(0)" ::: "memory");
        } else {
            XB_SPIN(xb_ld(&bar[XB_XGEN(b.x)]) == gen, bar);
            __builtin_amdgcn_fence(__ATOMIC_ACQUIRE, "agent");
            asm volatile("s_waitcnt vmcnt(0)" ::: "memory");
        }
    }
    __syncthreads();
}

typedef const __attribute__((address_space(4))) Args* KArgs;
#define MKP const int BID = opaque_bid(), GRD = opaque_grid(); (void)BID; (void)GRD; Ptrs P; unsigned char* ws; { KArgs ap = (KArgs)__builtin_amdgcn_kernarg_segment_ptr(); asm volatile("" : "+s"(ap)); \
    P.x = ap->in[0]; P.pre_g = ap->in[1]; P.post_g = ap->in[2]; P.w_in = ap->in[3]; P.conv_w = ap->in[4]; P.a_log = ap->in[5]; P.dt_bias = ap->in[6]; P.dn_g = ap->in[7]; \
    P.a_re = ap->in[8]; P.a_im = ap->in[9]; P.b_re = ap->in[10]; P.b_im = ap->in[11]; P.c_re = ap->in[12]; P.c_im = ap->in[13]; P.sd = ap->in[14]; P.log_dt = ap->in[15]; \
    P.glu_w = ap->in[16]; P.glu_b = ap->in[17]; P.w_out = ap->in[18]; P.out = ap->out; ws = ap->ws; \
    P.XN = (bf16*)(ws + WS_XN); P.MIXIN = P.XN; P.QKVR = (bf16*)(ws + WS_QKV); P.MIXO = (bf16*)(ws + WS_MIXO); P.YS = (bf16*)(ws + WS_YS); \
    P.ZDN = (bf16*)(ws + WS_ZDN); P.ZS = (bf16*)(ws + WS_ZS); P.UGX = (bf16*)(ws + WS_UGX); \
    P.BETA = (float*)(ws + WS_BETA); P.GLOG = (float*)(ws + WS_GLOG); P.SSQ = (float*)(ws + WS_SSQ); } \
    const DnBufs DB{(bf16*)(ws + WS_DNUT), (bf16*)(ws + WS_DNW), (bf16*)(ws + WS_DNQG), (bf16*)(ws + WS_DNKD), (bf16*)(ws + WS_DNIN), (float*)(ws + WS_GLAST)}; \
    bf16* const TF = (bf16*)(ws + WS_TF); bf16* const WE = (bf16*)(ws + WS_WE); float* const EST = (float*)(ws + WS_EST); float* const KTAB = (float*)(ws + WS_KTAB); (void)DB; (void)TF; (void)WE; (void)EST; (void)KTAB;
#define KARG() ({ KArgs ap_ = (KArgs)__builtin_amdgcn_kernarg_segment_ptr(); asm volatile("" : "+s"(ap_)); ap_; })
#define IN(k) ({ KArgs q_ = KARG(); q_->lo <= (k) && (k) < q_->hi; })
#define SEAM(k) do { if (IN(k) && IN((k) + 1)) { { KArgs q2_ = KARG(); XcdBarrier xb_; xb_.bar = (unsigned*)(q2_->ws + WS_CTL) + 1024; xb_.x = xb_xcc_id(); \
        xb_.st = (volatile LAS unsigned*)((LAS unsigned char*)lds + MISC_OFF) + 8; xcd_barrier(xb_); } } } while (0)
template <int l>
__device__ __forceinline__ void layer_phases(unsigned char* lds, cg::grid_group& grid) {
        for (int rep_ = 0; rep_ < (PROBE_REP == 0 ? 2 : 1); ++rep_) if (IN(NPH * l + 0)) {
            MKP
            if (l == 0) { prologue_weights((LAS unsigned char*)lds, P, ws); p0_norm((LAS unsigned char*)lds, P, 0, 0, P.x, nullptr, nullptr, P.pre_g); }
            else p0_norm((LAS unsigned char*)lds, P, l, 1, l == 1 ? P.x : P.out, P.out, P.post_g + (l - 1) * D, P.pre_g + l * D);
#if FAST_S5
            s5_build((LAS unsigned char*)lds, P, l, TF, WE, KTAB);
#endif
        }
        SEAM(NPH * l + 0);
        for (int rep_ = 0; rep_ < (PROBE_REP == 1 ? 2 : 1); ++rep_) if (IN(NPH * l + 1)) {
            MKP
#if FAST_P1
            pg8::Gemm g{P.XN, (const bf16*)(ws + WS_WIN) + (size_t)l * 3072 * D, D, D, D, 1 << 20};
            pg8::StaticOrder S; S.init(T, 3072, GRD, BID);
            EpiInProj E{P.QKVR, P.ZDN, P.ZS, P.UGX, P.BETA, P.GLOG, P.a_log + l * 4, P.dt_bias + l * 4};
            pg8::gemm_phase<EpiInProj, pg8::StaticOrder>((LAS unsigned char*)lds, g, S, E);
#else
            ngemm<0>(lds, P, l, P.XN, D, P.w_in + (size_t)l * D * INC, INC, INC, D);
#endif
        }
        SEAM(NPH * l + 1);
        for (int rep_ = 0; rep_ < (PROBE_REP == 2 ? 2 : 1); ++rep_) if (IN(NPH * l + 2)) {
            MKP
#if FAST_DN
            dn_chunk((LAS unsigned char*)lds, P, l, DB, TF, KTAB);
#endif
        }
        SEAM(NPH * l + 2);
        for (int rep_ = 0; rep_ < (PROBE_REP == 3 ? 2 : 1); ++rep_) if (IN(NPH * l + 3)) {
            MKP
#if FAST_DN
            dn_scan((LAS unsigned char*)lds, P, l, DB);
#else
            dn_naive(lds, P, l);
#endif
#if FAST_S5
            {
                const int nb = GRD / 2, c0 = BID - nb, cnt = GRD - nb;
                const int c = (c0 >= 0 && (cnt & 7) == 0) ? (c0 & 7) * (cnt >> 3) + (c0 >> 3) : c0;
                if (c >= 0) {
                    {
                        pg8::Gemm ge{P.UGX, WE, UGX_LD, 1024, 1024, 4};
                        S5EOrder SE{1, cnt, c};
                        EpiEst EE{EST};
                        pg8::gemm_phase<EpiEst, S5EOrder>((LAS unsigned char*)lds, ge, SE, EE);
                        asm volatile("s_waitcnt vmcnt(0)" ::: "memory");
                        __syncthreads();
                    }
                    const int tid = opaque_tid();
                    for (int pm = c; pm < NG * 4; pm += cnt) s5_carry(P, l, pm, EST, P.UGX, tid);
                    asm volatile("s_waitcnt vmcnt(0)" ::: "memory");
                    __syncthreads();
                    pg8::Gemm g{P.UGX, TF, UGX_LD, UGX_LD, UGX_LD, 4};
                    S5Order S{4, cnt, c};
                    EpiS5 E{P.YS};
                    pg8::gemm_phase<EpiS5, S5Order>((LAS unsigned char*)lds, g, S, E);
                }
            }
#else
            s5_naive(P, l);
#endif
        }
        SEAM(NPH * l + 3);
        for (int rep_ = 0; rep_ < (PROBE_REP == 4 ? 2 : 1); ++rep_) if (IN(NPH * l + 4)) {
            MKP
#if FAST_P3
            pg8::Gemm g{P.YS, (const bf16*)(ws + WS_WGLU) + (size_t)l * 1024 * SW, SW, SW, SW, 1 << 20};
            pg8::StaticOrder S; S.init(T, 1024, GRD, BID);
            EpiGlu E{P.MIXIN, P.ZS, P.glu_b + l * 1024};
            pg8::gemm_phase<EpiGlu, pg8::StaticOrder>((LAS unsigned char*)lds, g, S, E);
#else
            ngemm<1>(lds, P, l, P.YS, SW, P.glu_w + (size_t)l * SW * 1024, 1024, 512, SW);
#endif
        }
        SEAM(NPH * l + 4);
        for (int rep_ = 0; rep_ < (PROBE_REP == 5 ? 2 : 1); ++rep_) if (IN(NPH * l + 5)) {
            MKP
#if FAST_P4
            pg8::Gemm g{P.MIXIN, (const bf16*)(ws + WS_WOUT) + (size_t)l * D * D, D, D, D, 1 << 20};
            pg8::StaticOrder S; S.init(T, D, GRD, BID);
            EpiOut E{P.MIXO, P.SSQ};
            pg8::gemm_phase<EpiOut, pg8::StaticOrder>((LAS unsigned char*)lds, g, S, E);
#else
            ngemm<2>(lds, P, l, P.MIXIN, D, P.w_out + (size_t)l * D * D, D, D, D);
#endif
        }
        SEAM(NPH * l + 5);
    }

__global__ void __launch_bounds__(NTHREADS, 2) fwd(Args a) {
    extern __shared__ __attribute__((aligned(16))) unsigned char lds[];
    cg::grid_group grid = cg::this_grid();
    volatile LAS unsigned* MISC = (volatile LAS unsigned*)((LAS unsigned char*)lds + MISC_OFF);
    if (threadIdx.x < 32) MISC[threadIdx.x] = 0u;
    __syncthreads();
    (void)xcd_barrier_post((unsigned*)(a.ws + WS_CTL) + 1024, MISC + 8);
    layer_phases<0>(lds, grid);
    layer_phases<1>(lds, grid);
    static_assert(DEPTH == 2, "two explicit layer instantiations");
    if (IN(NPH * DEPTH)) { MKP p0_norm((LAS unsigned char*)lds, P, 0, 2, P.out, P.out, P.post_g + (DEPTH - 1) * D, nullptr); }
#undef IN
#undef SEAM
}

extern "C" void kernel_launch(void* const* d_in, const int* in_sizes, int n_in, void* d_out, int out_size, void* d_ws, size_t ws_size, hipStream_t stream) {
    static int grid = 0;
    if (grid == 0) {
        if (n_in != 19 || in_sizes[0] != T * D || out_size != T * D || ws_size < WS_END) {
            fprintf(stderr, "kernel_launch: unexpected shapes/workspace: n_in %d in0 %d out %d ws %zu (need %zu)\n", n_in, n_in > 0 ? in_sizes[0] : -1, out_size, ws_size, (size_t)WS_END);
            grid = -1; return;
        }
        int dev = 0, cus = 0, per_cu = 0;
        hipGetDevice(&dev);
        hipDeviceGetAttribute(&cus, hipDeviceAttributeMultiprocessorCount, dev);
        hipFuncSetAttribute((const void*)fwd, hipFuncAttributeMaxDynamicSharedMemorySize, LDS_BYTES);
        hipOccupancyMaxActiveBlocksPerMultiprocessor(&per_cu, (const void*)fwd, NTHREADS, LDS_BYTES);
        if (per_cu < 1) { fprintf(stderr, "kernel_launch: occupancy query says %d blocks/CU\n", per_cu); per_cu = 1; }
        (void)hipGetLastError();
        grid = cus;
        fprintf(stderr, "kernel_launch: cus %d per_cu %d grid %d ws %zu\n", cus, per_cu, grid, ws_size);
    }
    if (grid < 0) return;
    if (hipMemsetAsync((char*)d_ws + WS_CTL, 0, CTL_ZERO_BYTES, stream) != hipSuccess) { fprintf(stderr, "kernel_launch: memset failed\n"); return; }
    Args a{};
    for (int i = 0; i < 19; ++i) a.in[i] = (const float*)d_in[i];
    a.out = (float*)d_out; a.ws = (unsigned char*)d_ws; a.lo = 0; a.hi = NPH * DEPTH + 1;
    void* args[] = {&a};
    hipError_t e = hipLaunchCooperativeKernel((const void*)fwd, dim3(grid), dim3(NTHREADS), args, LDS_BYTES, stream);
    if (e != hipSuccess) fprintf(stderr, "cooperative launch failed: %s (grid %d)\n", hipGetErrorString(e), grid);
}
```

```cpp
#include <hip/hip_runtime.h>
#include <hip/hip_cooperative_groups.h>
#include <cstdio>
#include <cstdint>
namespace cg = cooperative_groups;
#ifndef PROBE_REP
#define PROBE_REP -1
#endif
#ifndef FAST_P1
#define FAST_P1 1
#endif
#ifndef FAST_P3
#define FAST_P3 1
#endif
#ifndef FAST_P4
#define FAST_P4 1
#endif
#ifndef FAST_S5
#define FAST_S5 1
#endif
#ifndef FAST_DN
#define FAST_DN 1
#endif

constexpr int D = 1024, BATCH = 32, SEQ = 2048, DEPTH = 2, T = BATCH * SEQ;
constexpr int NH = 4, HD = 128, DNW = 512, QKV = 1536;
constexpr int NG = 32, SGC = 16, SP = 64, SW = 512;
constexpr int INC = 3080;
constexpr int C_ZDN = 1536, C_BETA = 2048, C_ALPHA = 2052, C_U = 2056, C_ZS = 2568;
constexpr float EPS = 1e-6f;
constexpr int NTHREADS = 512, NWAVES = 8;
constexpr int LDS_BYTES = 155648;
constexpr int NPH = 6;
constexpr int MISC_OFF = 153600;
constexpr size_t CTL_ZERO_BYTES = 65536;

typedef unsigned short bf16;
typedef float f32x4 __attribute__((ext_vector_type(4)));
typedef float f32x2 __attribute__((ext_vector_type(2)));
#define LAS __attribute__((address_space(3)))
__device__ __forceinline__ float bf2f(bf16 v) { return __uint_as_float(((unsigned)v) << 16); }
typedef __bf16 bf16x2_t __attribute__((ext_vector_type(2)));
__device__ __forceinline__ unsigned cvtpk(float lo, float hi) { bf16x2_t v; v[0] = (__bf16)lo; v[1] = (__bf16)hi; return __builtin_bit_cast(unsigned, v); }
__device__ __forceinline__ bf16 f2bf(float f) { return (bf16)(cvtpk(f, 0.f) & 0xffffu); }
__device__ __forceinline__ float siluf(float x) { return x * __builtin_amdgcn_rcpf(1.f + __expf(-x)); }
__device__ __forceinline__ float sigmf(float x) { return __builtin_amdgcn_rcpf(1.f + __expf(-x)); }
__device__ __forceinline__ float softplusf(float x) { return fmaxf(x, 0.f) + __logf(1.f + __expf(-fabsf(x))); }
__device__ __forceinline__ float gelu_tanh(float x) { const float u = 0.7978845608028654f * (x + 0.044715f * x * x * x); return 0.5f * x * (1.f + tanhf(u)); }
__device__ __forceinline__ int opaque_bid() { int t = blockIdx.x; asm volatile("" : "+s"(t)); return t; }
__device__ __forceinline__ int opaque_grid() { int t = gridDim.x; asm volatile("" : "+s"(t)); return t; }
__device__ __forceinline__ int opaque_tid() { int t = threadIdx.x; asm volatile("" : "+v"(t)); return t; }
#define DPPF(old_, v_, ctrl_, rmask_) __int_as_float(__builtin_amdgcn_update_dpp(__float_as_int(old_), __float_as_int(v_), (ctrl_), (rmask_), 0xF, false))
__device__ __forceinline__ float sum8_dpp(float v) {
    v += DPPF(0.f, v, 0xB1, 0xF); v += DPPF(0.f, v, 0x4E, 0xF); v += DPPF(0.f, v, 0x141, 0xF);
    return v;
}
__device__ __forceinline__ float wave_sum(float v) {
    v = sum8_dpp(v);
    v += DPPF(0.f, v, 0x140, 0xF);
    v += DPPF(0.f, v, 0x142, 0xA);
    v += DPPF(0.f, v, 0x143, 0xC);
    return __int_as_float(__builtin_amdgcn_readlane(__float_as_int(v), 63));
}
__device__ __forceinline__ float wave_scan_incl(float v) {
    v += DPPF(0.f, v, 0x111, 0xF); v += DPPF(0.f, v, 0x112, 0xF); v += DPPF(0.f, v, 0x114, 0xF); v += DPPF(0.f, v, 0x118, 0xF);
    v += DPPF(0.f, v, 0x142, 0xA); v += DPPF(0.f, v, 0x143, 0xC);
    return v;
}

constexpr size_t MiB = 1u << 20;
constexpr size_t WS_CTL = 0;
constexpr size_t WS_WIN = 2 * MiB, WS_WGLU = 16 * MiB, WS_WOUT = 18 * MiB;
constexpr size_t WS_BETA = 22 * MiB, WS_GLOG = 23 * MiB, WS_SSQ = 24 * MiB;
constexpr size_t WS_XN = 32 * MiB;
constexpr size_t WS_QKV = 160 * MiB;
constexpr size_t WS_KTAB = 29 * MiB;
constexpr size_t WS_EST = 552 * MiB, WS_TF = 568 * MiB, WS_WE = 640 * MiB;
constexpr size_t WS_DNUT = 720 * MiB, WS_DNW = 784 * MiB, WS_DNQG = 848 * MiB, WS_DNKD = 912 * MiB, WS_DNIN = 976 * MiB, WS_GLAST = 28 * MiB;
constexpr size_t WS_MIXO = 160 * MiB, WS_YS = 656 * MiB;
constexpr size_t WS_ZDN = 352 * MiB, WS_ZS = 416 * MiB;
constexpr size_t WS_UGX = 480 * MiB;
constexpr size_t WS_END = 1008 * MiB;
constexpr int UGX_LD = 1152;

struct Args { const float* in[19]; float* out; unsigned char* ws; int lo, hi; };

struct Ptrs {
    const float *x, *pre_g, *post_g, *w_in, *conv_w, *a_log, *dt_bias, *dn_g, *a_re, *a_im, *b_re, *b_im, *c_re, *c_im, *sd, *log_dt, *glu_w, *glu_b, *w_out;
    float* out;
    bf16 *XN, *MIXIN, *QKVR, *MIXO, *YS, *ZDN, *ZS, *UGX;
    float *BETA, *GLOG, *SSQ;
};

__device__ __forceinline__ void p0_norm(LAS unsigned char* lds, const Ptrs& P, int l, int mode, const float* xsrc, float* xdst, const float* postg, const float* preg) {
    const int BID = opaque_bid(), GRD = opaque_grid(); (void)BID; (void)GRD;
    const int tid_ = opaque_tid(); const int lane = tid_ & 63, wave = tid_ >> 6;
    const int gw = BID * NWAVES + wave, ngw = GRD * NWAVES;
    LAS float* W8 = (LAS float*)lds;
    float alv = 0.f, dbv = 0.f;
    const int cidx = lane >> 3;
    if (mode != 2) {
        __syncthreads();
        for (int e = tid_; e < 8 * 1024; e += NTHREADS) { const int k = e >> 3, c = e & 7; W8[c * 1024 + k] = P.w_in[(size_t)l * D * INC + (size_t)k * INC + C_BETA + c]; }
        __syncthreads();
        if (cidx >= 4) { alv = P.a_log[l * 4 + cidx - 4]; dbv = P.dt_bias[l * 4 + cidx - 4]; }
    }
    struct RowSet { float4 x[4]; uint2 mx[4]; float ss; };
    RowSet SA, SB;
#define P0_LDX(row_, j_, dst_) do { if (mode == 2) { const uint2 t_ = ((const uint2*)(xsrc + (size_t)(row_) * D))[lane + 64 * (j_)]; \
        dst_ = make_float4(__uint_as_float(t_.x), __uint_as_float(t_.y), 0.f, 0.f); } \
        else { const f32x4 t4_ = __builtin_nontemporal_load((const f32x4*)(xsrc + (size_t)(row_) * D) + lane + 64 * (j_)); dst_ = make_float4(t4_[0], t4_[1], t4_[2], t4_[3]); } } while (0)
    LAS float* const Gpo = (LAS float*)lds + 8 * 1024; LAS float* const Gpr = Gpo + 1024;
    { if (mode == 2) __syncthreads();
      for (int e = tid_; e < 1024; e += NTHREADS) { Gpo[e] = mode != 0 ? postg[e] : 0.f; Gpr[e] = mode != 2 ? preg[e] : 0.f; }
      __syncthreads(); }
    auto row_load = [&](RowSet& S, const int r) __attribute__((always_inline)) {
#pragma unroll
        for (int j = 0; j < 4; ++j) P0_LDX(r, j, S.x[j]);
        if (mode != 0) {
            S.ss = P.SSQ[(size_t)r * 16 + (lane & 15)];
            const uint2* mr = (const uint2*)(P.MIXO + (size_t)r * D) + lane;
#pragma unroll
            for (int j = 0; j < 4; ++j) { const unsigned long long t8_ = __builtin_nontemporal_load((const unsigned long long*)(mr + 64 * j)); S.mx[j] = make_uint2((unsigned)t8_, (unsigned)(t8_ >> 32)); }
        } else { S.ss = 0.f;
#pragma unroll
            for (int j = 0; j < 4; ++j) S.mx[j] = make_uint2(0u, 0u); }
    };
    auto row_step = [&](RowSet& S, const int m, const int mnext) __attribute__((always_inline)) {
        float4 v[4]; uint2 mw[4]; float ss = S.ss;
#pragma unroll
        for (int j = 0; j < 4; ++j) { mw[j] = S.mx[j];
            if (mode == 2) { const unsigned a_ = __float_as_uint(S.x[j].x), b_ = __float_as_uint(S.x[j].y);
                v[j] = make_float4(bf2f((bf16)(a_ & 0xffff)), bf2f((bf16)(a_ >> 16)), bf2f((bf16)(b_ & 0xffff)), bf2f((bf16)(b_ >> 16))); }
            else v[j] = S.x[j]; }
        unsigned lb_ = 4u * (unsigned)lane; asm volatile("" : "+v"(lb_));
        LAS float* const Wl = (LAS float*)lds + lb_;
        if (mode != 0) {
            ss = wave_sum(lane < 16 ? ss : 0.f);
            f32x2 rq; rq[0] = __builtin_amdgcn_rsqf(ss * (1.f / D) + EPS); rq[1] = rq[0]; asm volatile("" : "+v"(rq));
#pragma unroll
            for (int j = 0; j < 4; ++j) {
                const uint2 w = mw[j];
                const f32x4 g4_ = *(const LAS f32x4*)(Wl + 8 * 1024 + 256 * j); const float4 g = make_float4(g4_[0], g4_[1], g4_[2], g4_[3]);
                v[j].x += bf2f((bf16)(w.x & 0xffff)) * rq[0] * g.x; v[j].y += bf2f((bf16)(w.x >> 16)) * rq[1] * g.y;
                v[j].z += bf2f((bf16)(w.y & 0xffff)) * rq[0] * g.z; v[j].w += bf2f((bf16)(w.y >> 16)) * rq[1] * g.w;
            }
            if (mode == 2) {
                f32x4* xo = (f32x4*)(xdst + (size_t)m * D) + lane;
#pragma unroll
                for (int j = 0; j < 4; ++j) __builtin_nontemporal_store((f32x4){v[j].x, v[j].y, v[j].z, v[j].w}, xo + 64 * j);
            } else {
                uint2* xo = (uint2*)(xdst + (size_t)m * D) + lane;
#pragma unroll
                for (int j = 0; j < 4; ++j) { uint2 w; w.x = cvtpk(v[j].x, v[j].y); w.y = cvtpk(v[j].z, v[j].w); __builtin_nontemporal_store((unsigned long long)w.x | ((unsigned long long)w.y << 32), (unsigned long long*)(xo + 64 * j));
                    v[j] = make_float4(bf2f((bf16)(w.x & 0xffff)), bf2f((bf16)(w.x >> 16)), bf2f((bf16)(w.y & 0xffff)), bf2f((bf16)(w.y >> 16))); }
            }
        }
        if (mode != 2) {
            float s = 0.f;
#pragma unroll
            for (int j = 0; j < 4; ++j) s += v[j].x * v[j].x + v[j].y * v[j].y + v[j].z * v[j].z + v[j].w * v[j].w;
            s = wave_sum(s);
            f32x2 rp; rp[0] = __builtin_amdgcn_rsqf(s * (1.f / D) + EPS); rp[1] = rp[0]; asm volatile("" : "+v"(rp));
            uint2* xo = (uint2*)(P.XN + (size_t)m * D) + lane;
            float dot[8];
#pragma unroll
            for (int c = 0; c < 8; ++c) dot[c] = 0.f;
#pragma unroll
            for (int j = 0; j < 4; ++j) {
                const f32x4 g4_ = *(const LAS f32x4*)(Wl + 9 * 1024 + 256 * j); const float4 g = make_float4(g4_[0], g4_[1], g4_[2], g4_[3]);
                const float h0 = v[j].x * rp[0] * g.x, h1 = v[j].y * rp[1] * g.y, h2 = v[j].z * rp[0] * g.z, h3 = v[j].w * rp[1] * g.w;
                uint2 w;
                w.x = cvtpk(h0, h1); w.y = cvtpk(h2, h3);
                xo[64 * j] = w;
#pragma unroll
                for (int c = 0; c < 8; ++c) { const f32x4 wv = *(const LAS f32x4*)(Wl + c * 1024 + 256 * j); dot[c] += h0 * wv[0] + h1 * wv[1] + h2 * wv[2] + h3 * wv[3]; }
            }
            float r4[4], r2[2], r1;
            {
                const bool hi = (lane & 32) != 0;
#pragma unroll
                for (int c = 0; c < 4; ++c) { const float keep = hi ? dot[c + 4] : dot[c], send = hi ? dot[c] : dot[c + 4]; r4[c] = keep + __shfl_xor(send, 32); }
            }
            {
                const bool hi = (lane & 16) != 0;
#pragma unroll
                for (int c = 0; c < 2; ++c) { const float keep = hi ? r4[c + 2] : r4[c], send = hi ? r4[c] : r4[c + 2]; r2[c] = keep + __shfl_xor(send, 16); }
            }
            {
                const bool hi = (lane & 8) != 0;
                const float keep = hi ? r2[1] : r2[0], send = hi ? r2[0] : r2[1]; r1 = keep + __shfl_xor(send, 8);
            }
            r1 = sum8_dpp(r1);
            {
                float* const dst = cidx < 4 ? P.BETA + (size_t)m * 4 + cidx : P.GLOG + (size_t)m * 4 + (cidx - 4);
                *dst = cidx < 4 ? sigmf(r1) : -__expf(alv) * softplusf(r1 + dbv);
            }
        }
        __builtin_amdgcn_sched_barrier(0);
        row_load(S, mnext < T ? mnext : m);
        __builtin_amdgcn_sched_barrier(0);
    };
    if (gw < T) {
        row_load(SA, gw); row_load(SB, gw + ngw < T ? gw + ngw : gw);
        int m = gw;
        if (m + ngw < T) {
            row_step(SA, m, m + 2 * ngw); row_step(SB, m + ngw, m + 3 * ngw); m += 2 * ngw;
            for (; m + ngw < T; m += 2 * ngw) { row_step(SA, m, m + 2 * ngw); row_step(SB, m + ngw, m + 3 * ngw); }
        }
        if (m < T) row_step(SA, m, m);
    }
#undef P0_LDX
}

template <int MODE>
__device__ __forceinline__ void ngemm(unsigned char* ldsb, const Ptrs& P, int l, const bf16* A, int lda, const float* W, int N, int Ncols, int K) {
    const int BID = opaque_bid(), GRD = opaque_grid(); (void)BID; (void)GRD;
    float* As = (float*)ldsb;
    float* Bs = As + 128 * 36;
    float* Bs2 = Bs + 32 * 64;
    const int tid = opaque_tid(), tx = tid & 63, ty = tid >> 6, lane = tid & 63;
    const int nct = (Ncols + 63) / 64, nrt = T / 128;
    for (int tile = BID; tile < nrt * nct; tile += GRD) {
        const int rt = tile / nct, ct = tile % nct;
        const int row0 = rt * 128, col0 = ct * 64;
        float acc[16], acc2[16];
#pragma unroll
        for (int r = 0; r < 16; ++r) { acc[r] = 0.f; acc2[r] = 0.f; }
        for (int k0 = 0; k0 < K; k0 += 32) {
            {
                const int r = tid >> 2, kq = (tid & 3) * 8;
                const uint4 v = *(const uint4*)(A + (size_t)(row0 + r) * lda + k0 + kq);
                float* d = As + r * 36 + kq;
                d[0] = bf2f((bf16)(v.x & 0xffff)); d[1] = bf2f((bf16)(v.x >> 16));
                d[2] = bf2f((bf16)(v.y & 0xffff)); d[3] = bf2f((bf16)(v.y >> 16));
                d[4] = bf2f((bf16)(v.z & 0xffff)); d[5] = bf2f((bf16)(v.z >> 16));
                d[6] = bf2f((bf16)(v.w & 0xffff)); d[7] = bf2f((bf16)(v.w >> 16));
            }
            {
                const int k = tid >> 4, c4 = (tid & 15) * 4;
#pragma unroll
                for (int j = 0; j < 4; ++j) {
                    const int col = col0 + c4 + j;
                    Bs[k * 64 + c4 + j] = col < Ncols ? W[(size_t)(k0 + k) * N + col] : 0.f;
                    if (MODE == 1) Bs2[k * 64 + c4 + j] = W[(size_t)(k0 + k) * N + col + 512];
                }
            }
            __syncthreads();
#pragma unroll 1
            for (int kk = 0; kk < 32; kk += 4) {
                const float b0 = Bs[(kk + 0) * 64 + tx], b1 = Bs[(kk + 1) * 64 + tx], b2 = Bs[(kk + 2) * 64 + tx], b3 = Bs[(kk + 3) * 64 + tx];
                float c0 = 0.f, c1 = 0.f, c2 = 0.f, c3 = 0.f;
                if (MODE == 1) { c0 = Bs2[(kk + 0) * 64 + tx]; c1 = Bs2[(kk + 1) * 64 + tx]; c2 = Bs2[(kk + 2) * 64 + tx]; c3 = Bs2[(kk + 3) * 64 + tx]; }
#pragma unroll
                for (int r = 0; r < 16; ++r) {
                    const float4 a4 = *(const float4*)(As + (ty * 16 + r) * 36 + kk);
                    acc[r] += a4.x * b0 + a4.y * b1 + a4.z * b2 + a4.w * b3;
                    if (MODE == 1) acc2[r] += a4.x * c0 + a4.y * c1 + a4.z * c2 + a4.w * c3;
                }
            }
            __syncthreads();
        }
        const int col = col0 + tx;
#pragma unroll
        for (int r = 0; r < 16; ++r) {
            const int row = row0 + ty * 16 + r;
            const float v = acc[r];
            if (MODE == 0) {
                if (col < Ncols) {
                    if (col < C_ZDN) P.QKVR[(size_t)row * QKV + col] = f2bf(v);
                    else if (col < C_BETA) P.ZDN[(size_t)row * 512 + (col - C_ZDN)] = f2bf(siluf(v));
                    else if (col < C_ALPHA) P.BETA[(size_t)row * 4 + (col - C_BETA)] = sigmf(v);
                    else if (col < C_U) { const int h = col - C_ALPHA; P.GLOG[(size_t)row * 4 + h] = -__expf(P.a_log[l * 4 + h]) * softplusf(v + P.dt_bias[l * 4 + h]); }
                    else if (col < C_ZS) { const int c = col - C_U, g = c >> 4, hh = c & 15, b = row >> 11, t = row & 2047;
                        P.UGX[((size_t)g * 1024 + b * 32 + (t >> 6)) * UGX_LD + (t & 63) * 16 + hh] = f2bf(v); }
                    else P.ZS[(size_t)row * 512 + (col - C_ZS)] = f2bf(siluf(v));
                }
            } else if (MODE == 1) {
                const float val = v + P.glu_b[l * 1024 + col], gate = acc2[r] + P.glu_b[l * 1024 + 512 + col];
                const float o = val * sigmf(gate) * bf2f(P.ZS[(size_t)row * 512 + col]);
                P.MIXIN[(size_t)row * D + 512 + col] = f2bf(o);
            } else {
                P.MIXO[(size_t)row * D + col] = f2bf(v);
                const float s = wave_sum(v * v);
                if (lane == 0) P.SSQ[(size_t)row * 16 + ct] = s;
            }
        }
    }
}

__device__ __forceinline__ void dn_naive(unsigned char* ldsb, const Ptrs& P, int l) {
    const int BID = opaque_bid(), GRD = opaque_grid(); (void)BID; (void)GRD;
    float* qs = (float*)ldsb; float* ks = qs + 128; float* vs = ks + 128; float* red = vs + 128; float* part = red + 16; float* part2 = part + 512;
    const int tid = opaque_tid(), wave = tid >> 6, lane = tid & 63;
    const int nb = GRD / 2;
    if (BID >= nb) return;
    for (int item = BID; item < BATCH * NH; item += nb) {
        const int b = item / NH, h = item % NH;
        float S[32];
#pragma unroll
        for (int i = 0; i < 32; ++i) S[i] = 0.f;
        const int dv = tid & 127, grp = tid >> 7;
        const int pid = tid >> 7, c = tid & 127;
        const int ch = (pid < 3 ? pid : 0) * 512 + h * 128 + c;
        float cw[4];
#pragma unroll
        for (int j = 0; j < 4; ++j) cw[j] = P.conv_w[(size_t)(l * 4 + j) * QKV + ch];
        const float ng = P.dn_g[l * 128 + dv];
        for (int t = 0; t < SEQ; ++t) {
            const int row = b * SEQ + t;
            float val = 0.f;
            if (tid < 384) {
                float a = 0.f;
#pragma unroll
                for (int j = 0; j < 4; ++j) { const int tt = t - 3 + j; if (tt >= 0) a += cw[j] * bf2f(P.QKVR[(size_t)(row - 3 + j) * QKV + ch]); }
                val = siluf(a);
                const float ss = wave_sum(val * val);
                if (lane == 0) red[wave] = ss;
            }
            __syncthreads();
            if (tid < 384) {
                if (pid < 2) { const float tot = red[2 * pid] + red[2 * pid + 1]; val *= __builtin_amdgcn_rsqf(tot + EPS); if (pid == 0) val *= 0.08838834764831845f; }
                (pid == 0 ? qs : (pid == 1 ? ks : vs))[c] = val;
            }
            __syncthreads();
            const float g = P.GLOG[(size_t)row * 4 + h], beta = P.BETA[(size_t)row * 4 + h];
            const float eg = __expf(g);
            float pp = 0.f;
#pragma unroll
            for (int i = 0; i < 32; ++i) { S[i] *= eg; pp += ks[grp * 32 + i] * S[i]; }
            part[grp * 128 + dv] = pp;
            __syncthreads();
            const float pred = part[dv] + part[128 + dv] + part[256 + dv] + part[384 + dv];
            const float delta = beta * (vs[dv] - pred);
            float op = 0.f;
#pragma unroll
            for (int i = 0; i < 32; ++i) { S[i] += ks[grp * 32 + i] * delta; op += qs[grp * 32 + i] * S[i]; }
            part2[grp * 128 + dv] = op;
            __syncthreads();
            float o = 0.f;
            if (tid < 128) {
                o = part2[tid] + part2[128 + tid] + part2[256 + tid] + part2[384 + tid];
                const float ss = wave_sum(o * o);
                if (lane == 0) red[8 + wave] = ss;
            }
            __syncthreads();
            if (tid < 128) {
                const float rinv = __builtin_amdgcn_rsqf((red[8] + red[9]) * (1.f / 128.f) + EPS);
                const float z = bf2f(P.ZDN[(size_t)row * 512 + h * 128 + tid]);
                P.MIXIN[(size_t)row * D + h * 128 + tid] = f2bf(o * rinv * ng * z);
            }
        }
        __syncthreads();
    }
}

__device__ __forceinline__ void s5_naive(const Ptrs& P, int l) {
    const int BID = opaque_bid(), GRD = opaque_grid(); (void)BID; (void)GRD;
    const int nb = GRD / 2;
    if (BID < nb) return;
    const int tid_ = opaque_tid(); const int lane = tid_ & 63, wave = tid_ >> 6;
    const int gw = (BID - nb) * NWAVES + wave, ngw = (GRD - nb) * NWAVES;
    for (int item = gw; item < BATCH * NG; item += ngw) {
        const int b = item / NG, g = item % NG, p = lane;
        const float dt = __expf(P.log_dt[l * NG + g]);
        const float are = P.a_re[(size_t)(l * NG + g) * SP + p], aim = P.a_im[(size_t)(l * NG + g) * SP + p];
        const float mag = __expf(are * dt), ang = aim * dt;
        float sn, cs; sincosf(ang, &sn, &cs);
        const float lr = mag * cs, li = mag * sn;
        const float den = are * are + aim * aim, nr = lr - 1.f, ni = li;
        const float cfr = (nr * are + ni * aim) / den, cfi = (ni * are - nr * aim) / den;
        float bbr[16], bbi[16], cr[16], ci[16];
#pragma unroll
        for (int hh = 0; hh < 16; ++hh) {
            const float br = P.b_re[((size_t)(l * NG + g) * SP + p) * 16 + hh], bi = P.b_im[((size_t)(l * NG + g) * SP + p) * 16 + hh];
            bbr[hh] = cfr * br - cfi * bi; bbi[hh] = cfr * bi + cfi * br;
            cr[hh] = P.c_re[((size_t)(l * NG + g) * 16 + hh) * SP + p]; ci[hh] = P.c_im[((size_t)(l * NG + g) * 16 + hh) * SP + p];
        }
        const float dd = lane < 16 ? P.sd[l * SW + g * 16 + lane] : 0.f;
        float xr = 0.f, xi = 0.f;
        for (int t = 0; t < SEQ; ++t) {
            const int row = b * SEQ + t;
            const bf16* up = P.UGX + ((size_t)g * 1024 + b * 32 + (t >> 6)) * UGX_LD + (t & 63) * 16;
            const uint4 u0 = *(const uint4*)up, u1 = *(const uint4*)(up + 8);
            float u[16];
            u[0] = bf2f((bf16)(u0.x & 0xffff)); u[1] = bf2f((bf16)(u0.x >> 16)); u[2] = bf2f((bf16)(u0.y & 0xffff)); u[3] = bf2f((bf16)(u0.y >> 16));
            u[4] = bf2f((bf16)(u0.z & 0xffff)); u[5] = bf2f((bf16)(u0.z >> 16)); u[6] = bf2f((bf16)(u0.w & 0xffff)); u[7] = bf2f((bf16)(u0.w >> 16));
            u[8] = bf2f((bf16)(u1.x & 0xffff)); u[9] = bf2f((bf16)(u1.x >> 16)); u[10] = bf2f((bf16)(u1.y & 0xffff)); u[11] = bf2f((bf16)(u1.y >> 16));
            u[12] = bf2f((bf16)(u1.z & 0xffff)); u[13] = bf2f((bf16)(u1.z >> 16)); u[14] = bf2f((bf16)(u1.w & 0xffff)); u[15] = bf2f((bf16)(u1.w >> 16));
            float bur = 0.f, bui = 0.f;
#pragma unroll
            for (int hh = 0; hh < 16; ++hh) { bur += bbr[hh] * u[hh]; bui += bbi[hh] * u[hh]; }
            const float nxr = lr * xr - li * xi + bur, nxi = lr * xi + li * xr + bui;
            xr = nxr; xi = nxi;
            float my = 0.f, myu = 0.f;
#pragma unroll
            for (int hh = 0; hh < 16; ++hh) {
                const float y = wave_sum(cr[hh] * xr - ci[hh] * xi);
                if (lane == hh) { my = y; myu = u[hh]; }
            }
            if (lane < 16) P.YS[(size_t)row * SW + g * 16 + lane] = f2bf(gelu_tanh(my + dd * myu));
        }
    }
}

#define GAS __attribute__((address_space(1)))
typedef short bf16x8 __attribute__((ext_vector_type(8)));
typedef unsigned u32x4 __attribute__((ext_vector_type(4)));
namespace pg8 {
constexpr int BM = 256, BK = 64, HALF = 128, HTB = HALF * BK * 2, STAGE_BYTES = 8 * HTB, NXCD = 8, WGM = 8;
__host__ __device__ __forceinline__ int lds_byte(int r, int c) { const int st = (r >> 4) * 2 + (c >> 5), rr = r & 15, cc = c & 31, ob = rr * 64 + cc * 2; return st * 1024 + (ob ^ (((ob >> 9) & 1) << 5)); }
__host__ __device__ __forceinline__ void stage_rc(int b, int& R, int& C) { const int st = b / 1024, sb = b % 1024, swz = sb ^ (((sb >> 9) & 1) << 5); R = (st >> 1) * 16 + swz / 64; C = (st & 1) * 32 + (swz % 64) / 2; }
__host__ __device__ __forceinline__ int perm32(int rho) { const int n = rho >> 4, i = rho & 15; return 8 * (i >> 2) + 4 * n + (i & 3); }
struct Unit { int pm, pn; };
struct Gemm { const bf16* A; const bf16* Bt; int lda, ldb, K, mg; };
struct StaticOrder {
    int nM, nN, nwg, G, c;
    __device__ void init(int M, int N, int G_, int c_) { nM = M / BM; nN = N / BM; nwg = nM * nN; G = G_; c = c_; }
    __device__ bool next(int i, Unit& u) const {
        const long L = (long)i * G + c; if (L >= nwg) return false;
        int wgid = (int)L; { const int q = nwg / NXCD, r = nwg % NXCD, xcd = wgid % NXCD, off = wgid / NXCD; wgid = (xcd < r ? xcd * (q + 1) : r * (q + 1) + (xcd - r) * q) + off; }
        const int nig = WGM * nN, gid = wgid / nig, fm = gid * WGM, gsz = (nM - fm) < WGM ? (nM - fm) : WGM;
        u.pm = fm + ((wgid % nig) % gsz); u.pn = (wgid % nig) / gsz; return true;
    }
    __device__ __forceinline__ int ntiles(const Unit&, int nt) const { return nt; }
    __device__ __forceinline__ int koff(const Unit&, int t) const { return t; }
};
__device__ __forceinline__ unsigned cvt_pk_bf16(float lo, float hi) { return cvtpk(lo, hi); }

template <class Epi, class Sched>
__device__ __forceinline__ void gemm_phase(LAS unsigned char* lds, const Gemm g, const Sched& S, const Epi& E) {
    const int tid = opaque_tid(), wid = __builtin_amdgcn_readfirstlane(tid >> 6), lane = tid & 63, wr = wid >> 2, wc = wid & 3, fr = lane & 15, fq = lane >> 4;
    const int K = g.K, nt = K / BK;
    unsigned voffA, voffB;
    { int R, C; stage_rc(tid * 16, R, C); const int Rb = (R & ~31) + perm32(R & 31); voffA = (unsigned)(R * g.lda + C) * 2u; voffB = (unsigned)(Rb * g.ldb + C) * 2u; }
    const size_t p2A = (size_t)64 * g.lda * 2, p2B = (size_t)64 * g.ldb * 2;
    const size_t kstep = (size_t)(BK * 2);
    const size_t hstepA = (size_t)HALF * g.lda * 2, hstepB = (size_t)HALF * g.ldb * 2;
    const size_t tstepA = 2 * hstepA, tstepB = 2 * hstepB;
    const unsigned ldsw = (unsigned)wid * 1024u;
    const int aoff = lds_byte(wr * 64 + fr, fq * 8), boff = lds_byte(wc * 32 + fr, fq * 8);
#define PG8_SA(b, h) (((b) * 2 + (h)) * HTB)
#define PG8_SB(b, h) ((4 + (b) * 2 + (h)) * HTB)
#define PG8_P2(v) PG8_P2_##v
#define PG8_P2_voffA p2A
#define PG8_P2_voffB p2B
#define PG8_STAGE(bufoff, gbase, voff) do { \
        __builtin_amdgcn_global_load_lds((const unsigned*)((const char*)(gbase) + (voff)), (LAS unsigned*)(lds + (bufoff) + ldsw), 16, 0, 0); \
        __builtin_amdgcn_global_load_lds((const unsigned*)((const char*)(gbase) + PG8_P2(voff) + (voff)), (LAS unsigned*)(lds + (bufoff) + ldsw + 8192), 16, 0, 0); } while (0)
#define PG8_LDA(dst, b, h) do { _Pragma("unroll") for (int m = 0; m < 4; ++m) _Pragma("unroll") for (int k = 0; k < 2; ++k) dst[m][k] = *(const LAS bf16x8*)(lds + PG8_SA(b, h) + aoff + m * 2048 + k * 1024); } while (0)
#define PG8_LDB(dst, b, h) do { _Pragma("unroll") for (int n = 0; n < 2; ++n) _Pragma("unroll") for (int k = 0; k < 2; ++k) dst[n][k] = *(const LAS bf16x8*)(lds + PG8_SB(b, h) + boff + n * 2048 + k * 1024); } while (0)
#define PG8_MMA(ai, bj, At, Bt) do { __builtin_amdgcn_s_setprio(1); _Pragma("unroll") for (int m = 0; m < 4; ++m) _Pragma("unroll") for (int n = 0; n < 2; ++n) _Pragma("unroll") for (int k = 0; k < 2; ++k) \
        acc[ai][bj][m][n] = __builtin_amdgcn_mfma_f32_16x16x32_bf16(Bt[n][k], At[m][k], acc[ai][bj][m][n], 0, 0, 0); __builtin_amdgcn_s_setprio(0); } while (0)
#define PG8_WAIT_V(n) asm volatile("s_waitcnt vmcnt(" #n ")" ::: "memory")
#define PG8_WAIT_L(n) asm volatile("s_waitcnt lgkmcnt(" #n ")" ::: "memory")
#define PG8_BAR __builtin_amdgcn_s_barrier()
#define PG8_SCHED __builtin_amdgcn_sched_barrier(0)
    Unit cur, nxt; int ui = 0;
    if (!S.next(0, cur)) return;
    int ntc = S.ntiles(cur, nt);
    f32x4 acc[2][2][4][2];
#pragma unroll
    for (int a = 0; a < 2; ++a)
#pragma unroll
        for (int b = 0; b < 2; ++b)
#pragma unroll
            for (int m = 0; m < 4; ++m)
#pragma unroll
                for (int n = 0; n < 2; ++n) acc[a][b][m][n] = (f32x4){0.f, 0.f, 0.f, 0.f};
    bf16x8 At[4][2], B0[2][2], B1[2][2];
    const char* cA = (const char*)g.A + (size_t)cur.pm * tstepA; const char* cB = (const char*)g.Bt + (size_t)((cur.pm / g.mg) * S.nN + cur.pn) * tstepB;
    PG8_STAGE(PG8_SB(0, 0), cB, voffB); PG8_STAGE(PG8_SB(0, 1), cB + hstepB, voffB); PG8_STAGE(PG8_SA(0, 0), cA, voffA); PG8_STAGE(PG8_SA(0, 1), cA + hstepA, voffA);
    if (wr == 1) PG8_BAR;
    PG8_WAIT_V(2); PG8_BAR;
    PG8_STAGE(PG8_SB(1, 0), cB + kstep, voffB); PG8_STAGE(PG8_SA(1, 0), cA + kstep, voffA); PG8_STAGE(PG8_SB(1, 1), cB + hstepB + kstep, voffB);
    PG8_WAIT_V(6); PG8_BAR;
    for (;;) {
        const bool has_next = S.next(ui + 1, nxt);
        const char* nA = has_next ? (const char*)g.A + (size_t)nxt.pm * tstepA : cA; const char* nB = has_next ? (const char*)g.Bt + (size_t)((nxt.pm / g.mg) * S.nN + nxt.pn) * tstepB : cB;
        for (int t = 0; t < ntc; t += 2) {
            const bool last = (t == ntc - 2);
            const size_t k1 = (size_t)S.koff(cur, t + 1) * kstep, k2 = (size_t)S.koff(cur, t + 2) * kstep, k3 = (size_t)S.koff(cur, t + 3) * kstep;
            const char* a1 = cA + k1;
            const char* a2 = last ? nA : cA + k2; const char* b2 = last ? nB : cB + k2;
            const char* a3 = last ? nA + kstep : cA + k3; const char* b3 = last ? nB + kstep : cB + k3;
            PG8_LDB(B0, 0, 0); PG8_LDB(B1, 0, 1); PG8_SCHED; PG8_LDA(At, 0, 0); PG8_STAGE(PG8_SA(1, 1), a1 + hstepA, voffA);
            PG8_WAIT_V(8); PG8_WAIT_L(0); PG8_BAR; PG8_MMA(0, 0, At, B0); PG8_MMA(0, 1, At, B1); PG8_BAR; PG8_SCHED;
            PG8_LDA(At, 0, 1); PG8_STAGE(PG8_SB(0, 0), b2, voffB); PG8_STAGE(PG8_SB(0, 1), b2 + hstepB, voffB); PG8_STAGE(PG8_SA(0, 0), a2, voffA);
            PG8_WAIT_V(8); PG8_WAIT_L(0); PG8_BAR; PG8_MMA(1, 0, At, B0); PG8_MMA(1, 1, At, B1); PG8_BAR; PG8_SCHED;
            PG8_LDB(B0, 1, 0); PG8_LDB(B1, 1, 1); PG8_SCHED; PG8_LDA(At, 1, 0); PG8_STAGE(PG8_SA(0, 1), a2 + hstepA, voffA);
            PG8_WAIT_V(8); PG8_WAIT_L(0); PG8_BAR; PG8_MMA(0, 0, At, B0); PG8_MMA(0, 1, At, B1); PG8_BAR; PG8_SCHED;
            PG8_LDA(At, 1, 1); PG8_STAGE(PG8_SB(1, 0), b3, voffB); PG8_STAGE(PG8_SB(1, 1), b3 + hstepB, voffB); PG8_STAGE(PG8_SA(1, 0), a3, voffA);
            PG8_WAIT_V(8); PG8_WAIT_L(0); PG8_BAR; PG8_MMA(1, 0, At, B0); PG8_MMA(1, 1, At, B1); PG8_BAR; PG8_SCHED;
        }
        if (wr == 0) PG8_BAR;
        E(acc, cur, wr, wc, fr, fq);
        if (!has_next) break;
#pragma unroll
        for (int a = 0; a < 2; ++a)
#pragma unroll
            for (int b = 0; b < 2; ++b)
#pragma unroll
                for (int m = 0; m < 4; ++m)
#pragma unroll
                    for (int n = 0; n < 2; ++n) acc[a][b][m][n] = (f32x4){0.f, 0.f, 0.f, 0.f};
        cur = nxt; cA = nA; cB = nB; ++ui; ntc = S.ntiles(cur, nt);
        if (wr == 1) PG8_BAR;
    }
    PG8_WAIT_V(0);
    PG8_BAR;
#undef PG8_SA
#undef PG8_SB
#undef PG8_STAGE
#undef PG8_LDA
#undef PG8_LDB
#undef PG8_MMA
#undef PG8_WAIT_V
#undef PG8_P2
#undef PG8_P2_voffA
#undef PG8_P2_voffB
#undef PG8_WAIT_L
#undef PG8_BAR
#undef PG8_SCHED
}
}

__device__ __forceinline__ u32x4 pack8(const f32x4 v0, const f32x4 v1) {
    u32x4 w; w.x = pg8::cvt_pk_bf16(v0[0], v0[1]); w.y = pg8::cvt_pk_bf16(v0[2], v0[3]); w.z = pg8::cvt_pk_bf16(v1[0], v1[1]); w.w = pg8::cvt_pk_bf16(v1[2], v1[3]); return w;
}
__device__ __forceinline__ f32x4 silu4(f32x4 v) { f32x4 r; r[0] = siluf(v[0]); r[1] = siluf(v[1]); r[2] = siluf(v[2]); r[3] = siluf(v[3]); return r; }
struct EpiInProj {
    static constexpr int NST = 16;
    bf16 *QKVR, *ZDN, *ZS, *UGX; float *BETA, *GLOG; const float *a_log, *dt_bias;
    __device__ __forceinline__ void operator()(const f32x4 (&acc)[2][2][4][2], const pg8::Unit& u, int wr, int wc, int fr, int fq) const {
        const int pn = u.pn, row0 = u.pm * 256 + wr * 64 + fr, cw = wc * 32 + 8 * fq;
#pragma unroll
        for (int ai = 0; ai < 2; ++ai)
#pragma unroll
            for (int m = 0; m < 4; ++m) {
                const int row = row0 + ai * 128 + m * 16;
#pragma unroll
                for (int bj = 0; bj < 2; ++bj) {
                    f32x4 v0 = acc[ai][bj][m][0], v1 = acc[ai][bj][m][1];
                    const int ct = bj * 128 + cw;
                    bf16* dst;
                    if (pn < 6) dst = QKVR + (size_t)row * QKV + pn * 256 + ct;
                    else if (pn < 8) { v0 = silu4(v0); v1 = silu4(v1); dst = ZDN + (size_t)row * 512 + (pn - 6) * 256 + ct; }
                    else if (pn < 10) { const int c = (pn - 8) * 256 + ct; dst = UGX + ((size_t)(c >> 4) * 1024 + (row >> 6)) * UGX_LD + (row & 63) * 16 + (c & 15); }
                    else { v0 = silu4(v0); v1 = silu4(v1); dst = ZS + (size_t)row * 512 + (pn - 10) * 256 + ct; }
                    *(u32x4*)dst = pack8(v0, v1);
                }
            }
    }
};
struct EpiGlu {
    static constexpr int NST = 8;
    bf16* MIXIN; const bf16* ZS; const float* glu_b;
    __device__ __forceinline__ void operator()(const f32x4 (&acc)[2][2][4][2], const pg8::Unit& u, int wr, int wc, int fr, int fq) const {
        const int row0 = u.pm * 256 + wr * 64 + fr, col = u.pn * 128 + wc * 32 + 8 * fq;
        const f32x4 bv0 = *(const f32x4*)(glu_b + col), bv1 = *(const f32x4*)(glu_b + col + 4), bg0 = *(const f32x4*)(glu_b + 512 + col), bg1 = *(const f32x4*)(glu_b + 512 + col + 4);
#pragma unroll
        for (int ai = 0; ai < 2; ++ai)
#pragma unroll
            for (int m = 0; m < 4; ++m) {
                const int row = row0 + ai * 128 + m * 16;
                const u32x4 z = *(const u32x4*)(ZS + (size_t)row * 512 + col);
                const f32x4 a0 = acc[ai][0][m][0] + bv0, a1 = acc[ai][0][m][1] + bv1, g0 = acc[ai][1][m][0] + bg0, g1 = acc[ai][1][m][1] + bg1;
                f32x4 o0, o1;
                o0[0] = a0[0] * sigmf(g0[0]) * bf2f((bf16)(z.x & 0xffff)); o0[1] = a0[1] * sigmf(g0[1]) * bf2f((bf16)(z.x >> 16));
                o0[2] = a0[2] * sigmf(g0[2]) * bf2f((bf16)(z.y & 0xffff)); o0[3] = a0[3] * sigmf(g0[3]) * bf2f((bf16)(z.y >> 16));
                o1[0] = a1[0] * sigmf(g1[0]) * bf2f((bf16)(z.z & 0xffff)); o1[1] = a1[1] * sigmf(g1[1]) * bf2f((bf16)(z.z >> 16));
                o1[2] = a1[2] * sigmf(g1[2]) * bf2f((bf16)(z.w & 0xffff)); o1[3] = a1[3] * sigmf(g1[3]) * bf2f((bf16)(z.w >> 16));
                *(u32x4*)(MIXIN + (size_t)row * D + 512 + col) = pack8(o0, o1);
            }
    }
};
struct EpiOut {
    static constexpr int NST = 24;
    bf16* MIXO; float* SSQ;
    __device__ __forceinline__ void operator()(const f32x4 (&acc)[2][2][4][2], const pg8::Unit& u, int wr, int wc, int fr, int fq) const {
        const int row0 = u.pm * 256 + wr * 64 + fr, col0 = u.pn * 256 + wc * 32 + 8 * fq;
#pragma unroll
        for (int ai = 0; ai < 2; ++ai)
#pragma unroll
            for (int m = 0; m < 4; ++m) {
                const int row = row0 + ai * 128 + m * 16;
                float s = 0.f;
#pragma unroll
                for (int bj = 0; bj < 2; ++bj) {
                    const f32x4 v0 = acc[ai][bj][m][0], v1 = acc[ai][bj][m][1];
                    s += (v0[0] * v0[0] + v0[1] * v0[1]) + (v0[2] * v0[2] + v0[3] * v0[3]) + (v1[0] * v1[0] + v1[1] * v1[1]) + (v1[2] * v1[2] + v1[3] * v1[3]);
                    *(u32x4*)(MIXO + (size_t)row * D + col0 + bj * 128) = pack8(v0, v1);
                }
                s += __shfl_xor(s, 16); s += __shfl_xor(s, 32);
                if (fq == 0) SSQ[(size_t)row * 16 + u.pn * 4 + wc] = s;
            }
    }
};

__device__ __forceinline__ unsigned pk2(float lo, float hi) { return cvtpk(lo, hi); }
template <int KIND> __device__ __forceinline__ int wsrc(int n) {
    if (KIND == 0) return n < 2048 ? n : n + 8;
    if (KIND == 1) { const int pn = n >> 8, j = n & 255; return j < 128 ? pn * 128 + j : 512 + pn * 128 + (j - 128); }
    return n;
}
template <int KIND>
__device__ __forceinline__ void transpose_item(const float* W, int K, int N, bf16* WT, LAS float* scr, int item, int nblk, int lane) {
    const int kb = item / nblk, nb = item % nblk, k0 = 64 * kb, n0 = 32 * nb;
    const int sc = wsrc<KIND>(n0 + (lane & 31));
#pragma unroll 8
    for (int i = 0; i < 32; ++i) { const int kk = 2 * i + (lane >> 5); scr[kk * 33 + (lane & 31)] = sc >= 0 ? W[(size_t)(k0 + kk) * N + sc] : 0.f; }
    asm volatile("s_waitcnt lgkmcnt(0)" ::: "memory");
    const int c = lane & 7;
#pragma unroll
    for (int j = 0; j < 4; ++j) { const int n = (lane >> 3) + 8 * j; const LAS float* s = scr + (8 * c) * 33 + n;
        u32x4 o; o.x = pk2(s[0 * 33], s[1 * 33]); o.y = pk2(s[2 * 33], s[3 * 33]); o.z = pk2(s[4 * 33], s[5 * 33]); o.w = pk2(s[6 * 33], s[7 * 33]);
        *(u32x4*)(WT + (size_t)(n0 + n) * K + k0 + 8 * c) = o; }
    asm volatile("s_waitcnt lgkmcnt(0)" ::: "memory");
}
__device__ __forceinline__ void prologue_weights(LAS unsigned char* lds, const Ptrs& P, unsigned char* ws) {
    const int BID = opaque_bid(), GRD = opaque_grid(); (void)BID; (void)GRD;
    const int tid_ = opaque_tid(); const int lane = tid_ & 63, wave = __builtin_amdgcn_readfirstlane(tid_ >> 6);
    LAS float* scr = (LAS float*)(lds + wave * 16384);
    const int gw = BID * NWAVES + wave, ngw = GRD * NWAVES;
    constexpr int I_IN = (D / 64) * (3072 / 32), I_GLU = (SW / 64) * (1024 / 32), I_OUT = (D / 64) * (D / 32);
    constexpr int PER = I_IN + I_GLU + I_OUT;
    for (int it = gw; it < DEPTH * PER; it += ngw) {
        const int l = it / PER; int r = it % PER;
        if (r < I_IN) { transpose_item<0>(P.w_in + (size_t)l * D * INC, D, INC, (bf16*)(ws + WS_WIN) + (size_t)l * 3072 * D, scr, r, 3072 / 32, lane); continue; } r -= I_IN;
        if (r < I_GLU) { transpose_item<1>(P.glu_w + (size_t)l * SW * 1024, SW, 1024, (bf16*)(ws + WS_WGLU) + (size_t)l * 1024 * SW, scr, r, 1024 / 32, lane); continue; } r -= I_GLU;
        transpose_item<2>(P.w_out + (size_t)l * D * D, D, D, (bf16*)(ws + WS_WOUT) + (size_t)l * D * D, scr, r, D / 32, lane);
    }
}

__device__ __forceinline__ float gelu_fast(float x) { return x * __builtin_amdgcn_rcpf(1.f + __expf(-1.5957691216057308f * (x + 0.044715f * x * x * x))); }
__device__ __forceinline__ void s5_lambda(const Ptrs& P, int l, int g, int p, int tau, float& lr, float& li) {
    const float dt = __expf(P.log_dt[l * NG + g]);
    const float are = P.a_re[(size_t)(l * NG + g) * SP + p], aim = P.a_im[(size_t)(l * NG + g) * SP + p];
    const float mag = __expf((float)tau * are * dt);
    const double rev = (double)tau * (double)aim * (double)dt * 0.15915494309189535;
    const float fr = (float)(rev - rint(rev));
    lr = mag * __cosf(fr * 6.283185307179586f); li = mag * __sinf(fr * 6.283185307179586f);
}
__device__ __forceinline__ void s5_build(LAS unsigned char* lds, const Ptrs& P, int l, bf16* TF, bf16* WE, float* KTAB) {
    const int BID = opaque_bid(), GRD = opaque_grid(); (void)BID; (void)GRD;
    LAS float* LTr = (LAS float*)lds;
    LAS float* LTi = LTr + 65 * 64;
    LAS float* CR = LTi + 65 * 64;
    LAS float* CI = CR + 16 * 64;
    LAS float* BBR = CI + 16 * 64;
    LAS float* BBI = BBR + 64 * 16;
    const int tid = opaque_tid();
    for (int item = BID; item < NG * 8; item += GRD) {
        const int g = item >> 3, part = item & 7;
        __syncthreads();
        for (int e = tid; e < 65 * 64; e += NTHREADS) { float lr, li; s5_lambda(P, l, g, e & 63, e >> 6, lr, li); LTr[e] = lr; LTi[e] = li; }
        if (tid < 64) {
            const int p = tid;
            const float are = P.a_re[(size_t)(l * NG + g) * SP + p], aim = P.a_im[(size_t)(l * NG + g) * SP + p];
            float lr, li; s5_lambda(P, l, g, p, 1, lr, li);
            const float den = are * are + aim * aim, nr = lr - 1.f, ni = li;
            const float cfr = (nr * are + ni * aim) / den, cfi = (ni * are - nr * aim) / den;
#pragma unroll
            for (int hh = 0; hh < 16; ++hh) {
                const float br = P.b_re[((size_t)(l * NG + g) * SP + p) * 16 + hh], bi = P.b_im[((size_t)(l * NG + g) * SP + p) * 16 + hh];
                BBR[p * 16 + hh] = cfr * br - cfi * bi; BBI[p * 16 + hh] = cfr * bi + cfi * br;
                CR[hh * 64 + p] = P.c_re[((size_t)(l * NG + g) * 16 + hh) * SP + p]; CI[hh * 64 + p] = P.c_im[((size_t)(l * NG + g) * 16 + hh) * SP + p];
            }
        }
        __syncthreads();
        {
            const int h = (tid >> 4) & 15, hp = tid & 15, t0 = part * 8 + (tid >> 8);
            float sq[4] = {0.f, 0.f, 0.f, 0.f};
#pragma unroll 4
            for (int p = 0; p < 64; ++p) {
                const float cr = CR[h * 64 + p], ci = CI[h * 64 + p], br = BBR[p * 16 + hp], bi = BBI[p * 16 + hp];
                const float X = cr * br - ci * bi, Y = ci * br + cr * bi;
#pragma unroll
                for (int q = 0; q < 4; ++q) sq[q] += LTr[(t0 + 2 * q) * 64 + p] * X - LTi[(t0 + 2 * q) * 64 + p] * Y;
            }
#pragma unroll
            for (int q = 0; q < 4; ++q) {
                const int tau = t0 + 2 * q;
                float sv = sq[q];
                if (tau == 0 && h == hp) sv += P.sd[l * SW + g * 16 + h];
                KTAB[((size_t)g * 64 + tau) * 256 + h * 16 + hp] = sv;
            }
        }
        bf16* TFg = TF + (size_t)g * 1024 * UGX_LD;
        for (int e = tid; e < 128 * 16; e += NTHREADS) {
            const int rl = e >> 4, ck = e & 15, n = part * 128 + rl, i = n >> 4, h = n & 15, pp0 = ck * 8;
            float v[8];
#pragma unroll
            for (int x = 0; x < 8; ++x) {
                const int pp = pp0 + x, p = pp & 63;
                const float cr = CR[h * 64 + p], ci = CI[h * 64 + p], Lr = LTr[(i + 1) * 64 + p], Li = LTi[(i + 1) * 64 + p];
                v[x] = pp < 64 ? (cr * Lr - ci * Li) : -(cr * Li + ci * Lr);
            }
            u32x4 w; w.x = pk2(v[0], v[1]); w.y = pk2(v[2], v[3]); w.z = pk2(v[4], v[5]); w.w = pk2(v[6], v[7]);
            *(u32x4*)(TFg + (size_t)n * UGX_LD + 1024 + ck * 8) = w;
        }
        bf16* WEg = WE + (size_t)g * 256 * 1024;
        for (int e = tid; e < 16 * 128; e += NTHREADS) {
            const int rl = e >> 7, ck = e & 127, nn = part * 16 + rl, p = nn & 63, j = ck >> 1, hp0 = (ck & 1) * 8;
            const float Lr = LTr[(63 - j) * 64 + p], Li = LTi[(63 - j) * 64 + p];
            float v[8];
#pragma unroll
            for (int x = 0; x < 8; ++x) { const float br = BBR[p * 16 + hp0 + x], bi = BBI[p * 16 + hp0 + x]; v[x] = nn < 64 ? (Lr * br - Li * bi) : (Lr * bi + Li * br); }
            u32x4 w; w.x = pk2(v[0], v[1]); w.y = pk2(v[2], v[3]); w.z = pk2(v[4], v[5]); w.w = pk2(v[6], v[7]);
            *(u32x4*)(WEg + (size_t)nn * 1024 + ck * 8) = w;
        }
    }
    __syncthreads();
}
__device__ __forceinline__ void s5_expand(bf16* TF, const float* KTAB) {
    const int BID = opaque_bid(), GRD = opaque_grid();
    const int tid = opaque_tid();
    const unsigned nthr = (unsigned)GRD * NTHREADS;
    for (unsigned e0 = (unsigned)BID * NTHREADS + tid; e0 < (unsigned)NG * 1024u * 128u; e0 += 4u * nthr) {
        f32x4 a[4], c[4]; bool ok[4];
#pragma unroll
        for (int u = 0; u < 4; ++u) {
            const unsigned e = e0 + (unsigned)u * nthr;
            const int ck = e & 127, n = (e >> 7) & 1023, g = e >> 17, i = n >> 4, h = n & 15, j = ck >> 1, hp0 = (ck & 1) * 8;
            ok[u] = e < (unsigned)NG * 1024u * 128u && j <= i;
            const float* src = KTAB + ((size_t)g * 64 + (ok[u] ? i - j : 0)) * 256 + h * 16 + hp0;
            if (ok[u]) { a[u] = *(const f32x4*)src; c[u] = *(const f32x4*)(src + 4); } else { a[u] = (f32x4){0.f, 0.f, 0.f, 0.f}; c[u] = a[u]; }
        }
#pragma unroll
        for (int u = 0; u < 4; ++u) {
            const unsigned e = e0 + (unsigned)u * nthr;
            if (e < (unsigned)NG * 1024u * 128u && (int)((e & 127) >> 5) <= (int)(((e >> 7) & 1023) >> 8)) {
                const int ck = e & 127, n = (e >> 7) & 1023, g = e >> 17;
                u32x4 w; w.x = pk2(a[u][0], a[u][1]); w.y = pk2(a[u][2], a[u][3]); w.z = pk2(c[u][0], c[u][1]); w.w = pk2(c[u][2], c[u][3]);
                *(u32x4*)(TF + ((size_t)g * 1024 + n) * UGX_LD + ck * 8) = w;
            }
        }
    }
}
struct EpiEst {
    static constexpr int NST = 16;
    float* EST;
    __device__ __forceinline__ void operator()(const f32x4 (&acc)[2][2][4][2], const pg8::Unit& u, int wr, int wc, int fr, int fq) const {
        const int row0 = u.pm * 256 + wr * 64 + fr, col = wc * 32 + 8 * fq;
#pragma unroll
        for (int ai = 0; ai < 2; ++ai)
#pragma unroll
            for (int m = 0; m < 4; ++m) { float* d = EST + (size_t)(row0 + ai * 128 + m * 16) * 128 + col; *(f32x4*)d = acc[ai][0][m][0]; *(f32x4*)(d + 4) = acc[ai][0][m][1]; }
    }
};
struct S5Order {
    int nN, cnt, c;
    __device__ bool next(int i, pg8::Unit& u) const { const int pm = (i >> 2) * cnt + c; if (c < 0 || pm >= NG * 4) return false; u.pm = pm; u.pn = i & 3; return true; }
    __device__ __forceinline__ int ntiles(const pg8::Unit& u, int) const { return 4 * (u.pn + 1) + 2; }
    __device__ __forceinline__ int koff(const pg8::Unit& u, int t) const { const int km = 4 * (u.pn + 1); return t < km ? t : t + 16 - km; }
};
struct S5EOrder {
    int nN, cnt, c;
    __device__ bool next(int i, pg8::Unit& u) const { const int pm = i * cnt + c; if (c < 0 || pm >= NG * 4) return false; u.pm = pm; u.pn = 0; return true; }
    __device__ __forceinline__ int ntiles(const pg8::Unit&, int nt) const { return nt; }
    __device__ __forceinline__ int koff(const pg8::Unit&, int t) const { return t; }
};
__device__ __forceinline__ void s5_carry(const Ptrs& P, int l, int pm, const float* EST, bf16* UGX, int tid) {
    const int g = pm >> 2, bl = tid >> 6, p = tid & 63;
    float lr, li; s5_lambda(P, l, g, p, 64, lr, li);
    float xr = 0.f, xi = 0.f;
    const size_t row0 = (size_t)pm * 256 + bl * 32;
#pragma unroll 4
    for (int c = 0; c < 32; ++c) {
        const size_t row = row0 + c;
        UGX[row * UGX_LD + 1024 + p] = f2bf(xr); UGX[row * UGX_LD + 1088 + p] = f2bf(xi);
        const float er = __hip_atomic_load(EST + row * 128 + p, __ATOMIC_RELAXED, __HIP_MEMORY_SCOPE_AGENT), ei = __hip_atomic_load(EST + row * 128 + 64 + p, __ATOMIC_RELAXED, __HIP_MEMORY_SCOPE_AGENT);
        const float nr = lr * xr - li * xi + er, ni = lr * xi + li * xr + ei;
        xr = nr; xi = ni;
    }
}
struct EpiS5 {
    static constexpr int NST = 16;
    bf16* YS;
    __device__ __forceinline__ void operator()(const f32x4 (&acc)[2][2][4][2], const pg8::Unit& u, int wr, int wc, int fr, int fq) const {
        const int g = u.pm >> 2, rg0 = (u.pm & 3) * 256 + wr * 64 + fr;
#pragma unroll
        for (int ai = 0; ai < 2; ++ai)
#pragma unroll
            for (int m = 0; m < 4; ++m) {
                const int rg = rg0 + ai * 128 + m * 16;
                const size_t tok0 = (size_t)(rg >> 5) * SEQ + (rg & 31) * 64;
#pragma unroll
                for (int bj = 0; bj < 2; ++bj) {
                    const int col = u.pn * 256 + bj * 128 + wc * 32 + 8 * fq, i = col >> 4, h0 = col & 15;
                    f32x4 v0 = acc[ai][bj][m][0], v1 = acc[ai][bj][m][1];
#pragma unroll
                    for (int x = 0; x < 4; ++x) { v0[x] = gelu_fast(v0[x]); v1[x] = gelu_fast(v1[x]); }
                    *(u32x4*)(YS + (tok0 + i) * SW + g * 16 + h0) = pack8(v0, v1);
                }
            }
    }
};

typedef float f32x16 __attribute__((ext_vector_type(16)));
typedef unsigned u32x2 __attribute__((ext_vector_type(2)));
#define MFMA32(a, b, c) __builtin_amdgcn_mfma_f32_32x32x16_bf16((a), (b), (c), 0, 0, 0)
__device__ __forceinline__ bf16x8 ldf(const LAS unsigned char* base, int row, int ldb, int kb) { return *(const LAS bf16x8*)(base + row * ldb + kb); }
__device__ __forceinline__ int crow(int reg, int h) { return (reg & 3) + 8 * (reg >> 2) + 4 * h; }
__device__ __forceinline__ void unpack8(const u32x4 v, float* d) {
    d[0] = bf2f((bf16)(v.x & 0xffff)); d[1] = bf2f((bf16)(v.x >> 16)); d[2] = bf2f((bf16)(v.y & 0xffff)); d[3] = bf2f((bf16)(v.y >> 16));
    d[4] = bf2f((bf16)(v.z & 0xffff)); d[5] = bf2f((bf16)(v.z >> 16)); d[6] = bf2f((bf16)(v.w & 0xffff)); d[7] = bf2f((bf16)(v.w >> 16));
}
struct DnBufs { bf16 *UT, *W, *QG, *KDT, *INTRA; float* GLAST; };
constexpr int NITEM = BATCH * NH * (SEQ / 64);

__device__ __forceinline__ void dn_chunk(LAS unsigned char* lds, const Ptrs& P, int l, const DnBufs& B, bf16* TF, const float* KTAB) {
    const int BID = opaque_bid(), GRD = opaque_grid(); (void)BID; (void)GRD;
    LAS unsigned char* Kt = lds;
    LAS unsigned char* Qt = Kt + 17408;
    LAS unsigned char* KgT = Qt + 17408;
    LAS unsigned char* VbT = KgT + 18432;
    LAS unsigned char* KdT = VbT + 18432;
    LAS float* Am = (LAS float*)(KdT + 18432);
    LAS unsigned char* Tm = (LAS unsigned char*)Am + 17408;
    LAS unsigned char* AoT = Tm + 9216;
    LAS unsigned char* Dm = AoT + 9216;
    LAS unsigned char* DmT = Dm + 9216;
    LAS float* gcs = (LAS float*)(DmT + 9216);
    LAS float* bts = gcs + 64;
    LAS float* cws = bts + 64;
    LAS unsigned char* const RW0 = (LAS unsigned char*)Am, * const RW1 = Tm, * const RW2 = Dm;
    LAS unsigned char* Nm = Kt, *NT = Kt + 9216, *INm = Qt, *ZT = (LAS unsigned char*)Am, *Pm = Kt;
    const int tid0 = opaque_tid(), wave = __builtin_amdgcn_readfirstlane(tid0 >> 6);
    int tid = tid0, lane = tid0 & 63, h32 = lane >> 5, l31 = lane & 31;
#define REOPQ do { tid = tid0; asm volatile("" : "+v"(tid)); lane = tid & 63; h32 = lane >> 5; l31 = lane & 31; } while (0)
    int cur_hh = -1;
    u32x4 own[3][2], hal[3][2];
#define DN_LOAD_RAW(it_) do { const int it__ = (it_); const int chunk_ = it__ & 31, bh_ = it__ >> 5, hh_ = bh_ & 3, b_ = bh_ >> 2, row0_ = b_ * SEQ + chunk_ * 64; \
        const int r_ = tid >> 3, cg_ = tid & 7; \
        _Pragma("unroll") for (int part = 0; part < 3; ++part) { \
            const bf16* src = P.QKVR + (size_t)(row0_ + r_) * QKV + part * 512 + hh_ * 128 + cg_ * 16; \
            own[part][0] = *(const u32x4*)src; own[part][1] = *(const u32x4*)(src + 8); \
            if (r_ < 3 && chunk_ != 0) { const bf16* hs = src - (size_t)3 * QKV; hal[part][0] = *(const u32x4*)hs; hal[part][1] = *(const u32x4*)(hs + 8); } } } while (0)
    if (BID < NITEM) DN_LOAD_RAW(BID);
    float g_pf = 0.f, b_pf = 0.f;
    if (BID < NITEM && wave == 0) { const int bh2 = BID >> 5, r2 = (bh2 >> 2) * SEQ + (BID & 31) * 64 + lane; g_pf = P.GLOG[(size_t)r2 * 4 + (bh2 & 3)]; b_pf = P.BETA[(size_t)r2 * 4 + (bh2 & 3)]; }
    constexpr unsigned XTOT = (unsigned)NG * 1024u * 128u;
    const unsigned xnthr = (unsigned)GRD * NTHREADS, xgid = (unsigned)BID * NTHREADS + (unsigned)tid0, xsteps = (XTOT + xnthr - 1) / xnthr;
    unsigned xu = 0;
#define DN_XDEC(e_) const int ck = (e_) & 127, n = ((e_) >> 7) & 1023, g = ((e_) >> 17) & (NG - 1), i = n >> 4, h = n & 15, j = ck >> 1, hp0 = (ck & 1) * 8; \
        const bool need = (e_) < XTOT && (ck >> 5) <= (n >> 8), ok = j <= i; (void)need; (void)ok; (void)g; (void)h; (void)hp0
    for (int item = BID; item < NITEM; item += GRD) {
        REOPQ;
        const int chunk = item & 31, bh = item >> 5, hh = bh & 3, b = bh >> 2, row0 = b * SEQ + chunk * 64;
        f32x4 xa[2], xc[2];
#pragma unroll
        for (int q = 0; q < 2; ++q) {
            const unsigned e = xgid + (xu + (unsigned)q) * xnthr; DN_XDEC(e);
            const float* src = KTAB + ((size_t)g * 64 + (ok ? i - j : 0)) * 256 + h * 16 + hp0;
            xa[q] = *(const f32x4*)src; xc[q] = *(const f32x4*)(src + 4);
        }
        if (hh != cur_hh) {
            cur_hh = hh;
            for (int e = tid; e < 3 * 4 * 128; e += NTHREADS) { const int part = e >> 9, j = (e >> 7) & 3, c = e & 127; cws[e] = P.conv_w[(size_t)(l * 4 + j) * QKV + part * 512 + hh * 128 + c]; }
        }
        if (wave == 0) {
            float g = g_pf;
            g = wave_scan_incl(g);
            gcs[lane] = g; bts[lane] = b_pf;
            if (lane == 63) B.GLAST[item] = __expf(g);
            if (item + GRD < NITEM) { const int it2 = item + GRD, bh2 = it2 >> 5, r2 = (bh2 >> 2) * SEQ + (it2 & 31) * 64 + lane; g_pf = P.GLOG[(size_t)r2 * 4 + (bh2 & 3)]; b_pf = P.BETA[(size_t)r2 * 4 + (bh2 & 3)]; }
        }
        {
            const int r_ = tid >> 3, cg_ = tid & 7;
#pragma unroll
            for (int part = 0; part < 3; ++part) {
                LAS unsigned char* rw = part == 0 ? RW0 : (part == 1 ? RW1 : RW2);
                *(LAS u32x4*)(rw + (3 + r_) * 256 + cg_ * 32) = own[part][0]; *(LAS u32x4*)(rw + (3 + r_) * 256 + cg_ * 32 + 16) = own[part][1];
                if (r_ < 3) {
                    const u32x4 z4 = (u32x4){0u, 0u, 0u, 0u};
                    *(LAS u32x4*)(rw + r_ * 256 + cg_ * 32) = chunk != 0 ? hal[part][0] : z4; *(LAS u32x4*)(rw + r_ * 256 + cg_ * 32 + 16) = chunk != 0 ? hal[part][1] : z4;
                }
            }
        }
        const int r = tid >> 3, cg = tid & 7;
        __syncthreads(); REOPQ;
        {
            const float gc_r = gcs[r], beta_r = bts[r], glast = gcs[63];
            const float eg = __expf(gc_r), ed = __expf(glast - gc_r);
#pragma unroll
            for (int part = 0; part < 3; ++part) {
                float acc[16];
#pragma unroll
                for (int c = 0; c < 16; ++c) acc[c] = 0.f;
#pragma unroll
                for (int j = 0; j < 4; ++j) {
                    const LAS unsigned char* rw = (part == 0 ? RW0 : (part == 1 ? RW1 : RW2)) + (r + j) * 256 + cg * 32;
                    float x[16]; unpack8(*(const LAS u32x4*)rw, x); unpack8(*(const LAS u32x4*)(rw + 16), x + 8);
                    const LAS float* wp = cws + (part * 4 + j) * 128 + cg * 16;
#pragma unroll
                    for (int c4 = 0; c4 < 4; ++c4) { const f32x4 w = *(const LAS f32x4*)(wp + 4 * c4);
                        acc[4 * c4] += w[0] * x[4 * c4]; acc[4 * c4 + 1] += w[1] * x[4 * c4 + 1]; acc[4 * c4 + 2] += w[2] * x[4 * c4 + 2]; acc[4 * c4 + 3] += w[3] * x[4 * c4 + 3]; }
                }
                float ss = 0.f;
#pragma unroll
                for (int c = 0; c < 16; ++c) { acc[c] = siluf(acc[c]); ss += acc[c] * acc[c]; }
                if (part < 2) {
                    ss = sum8_dpp(ss);
                    const float rinv = __builtin_amdgcn_rsqf(ss + EPS) * (part == 0 ? 0.08838834764831845f : 1.f);
#pragma unroll
                    for (int c = 0; c < 16; ++c) acc[c] *= rinv;
                }
                if (part == 0) {
                    u32x4 w0, w1;
                    w0.x = pk2(acc[0], acc[1]); w0.y = pk2(acc[2], acc[3]); w0.z = pk2(acc[4], acc[5]); w0.w = pk2(acc[6], acc[7]);
                    w1.x = pk2(acc[8], acc[9]); w1.y = pk2(acc[10], acc[11]); w1.z = pk2(acc[12], acc[13]); w1.w = pk2(acc[14], acc[15]);
                    *(LAS u32x4*)(Qt + r * 272 + cg * 32) = w0; *(LAS u32x4*)(Qt + r * 272 + cg * 32 + 16) = w1;
                    u32x4 g0, g1;
                    g0.x = pk2(acc[0] * eg, acc[1] * eg); g0.y = pk2(acc[2] * eg, acc[3] * eg); g0.z = pk2(acc[4] * eg, acc[5] * eg); g0.w = pk2(acc[6] * eg, acc[7] * eg);
                    g1.x = pk2(acc[8] * eg, acc[9] * eg); g1.y = pk2(acc[10] * eg, acc[11] * eg); g1.z = pk2(acc[12] * eg, acc[13] * eg); g1.w = pk2(acc[14] * eg, acc[15] * eg);
                    bf16* qg = B.QG + (size_t)item * 8192 + r * 128 + cg * 16;
                    *(u32x4*)qg = g0; *(u32x4*)(qg + 8) = g1;
                } else if (part == 1) {
                    u32x4 w0, w1;
                    w0.x = pk2(acc[0], acc[1]); w0.y = pk2(acc[2], acc[3]); w0.z = pk2(acc[4], acc[5]); w0.w = pk2(acc[6], acc[7]);
                    w1.x = pk2(acc[8], acc[9]); w1.y = pk2(acc[10], acc[11]); w1.z = pk2(acc[12], acc[13]); w1.w = pk2(acc[14], acc[15]);
                    *(LAS u32x4*)(Kt + r * 272 + cg * 32) = w0; *(LAS u32x4*)(Kt + r * 272 + cg * 32 + 16) = w1;
                    const float sg = beta_r * eg;
                    const int swz = (((r >> 3) ^ cg) & 7) * 16 + (r & 7) * 2;
#pragma unroll
                    for (int c = 0; c < 16; c += 2) {
                        const unsigned wg = cvtpk(acc[c] * sg, acc[c + 1] * sg), wd = cvtpk(acc[c] * ed, acc[c + 1] * ed);
                        *(LAS bf16*)(KgT + (cg * 16 + c) * 144 + swz) = (bf16)(wg & 0xffffu); *(LAS bf16*)(KgT + (cg * 16 + c + 1) * 144 + swz) = (bf16)(wg >> 16);
                        *(LAS bf16*)(KdT + (cg * 16 + c) * 144 + swz) = (bf16)(wd & 0xffffu); *(LAS bf16*)(KdT + (cg * 16 + c + 1) * 144 + swz) = (bf16)(wd >> 16);
                    }
                } else {
                    const int swz = (((r >> 3) ^ cg) & 7) * 16 + (r & 7) * 2;
#pragma unroll
                    for (int c = 0; c < 16; c += 2) { const unsigned wv = cvtpk(acc[c] * beta_r, acc[c + 1] * beta_r);
                        *(LAS bf16*)(VbT + (cg * 16 + c) * 144 + swz) = (bf16)(wv & 0xffffu); *(LAS bf16*)(VbT + (cg * 16 + c + 1) * 144 + swz) = (bf16)(wv >> 16); }
                }
            }
        }
        __builtin_amdgcn_sched_barrier(0);
        if (item + GRD < NITEM) DN_LOAD_RAW(item + GRD);
        __syncthreads(); REOPQ;
        for (int e = tid; e < 2 * 9216 / 16; e += NTHREADS) *(LAS u32x4*)(Dm + e * 16) = (u32x4){0u, 0u, 0u, 0u};
        if (wave < 4) {
            const int ti = wave >> 1, tj = wave & 1;
            f32x16 acc;
#pragma unroll
            for (int x = 0; x < 16; ++x) acc[x] = 0.f;
            if (!(ti == 0 && tj == 1)) {
#pragma unroll
                for (int s = 0; s < 8; ++s) { const bf16x8 a = ldf(Kt, ti * 32 + l31, 272, s * 32 + h32 * 16), bq = ldf(Kt, tj * 32 + l31, 272, s * 32 + h32 * 16); acc = MFMA32(a, bq, acc); }
            }
            const int j = tj * 32 + l31; const float gj = gcs[j];
#pragma unroll
            for (int q = 0; q < 4; ++q) {
                const int i0 = ti * 32 + 8 * q + 4 * h32;
                float v[4];
#pragma unroll
                for (int k = 0; k < 4; ++k) { const int i = i0 + k; const float t = bts[i] * acc[4 * q + k] * __expf(gcs[i] - gj); v[k] = (i > j) ? t : 0.f; Am[i * 68 + j] = v[k]; }
                const bool off = (i0 >> 4) > (j >> 4);
                u32x2 w; w.x = off ? pk2(v[0], v[1]) : 0u; w.y = off ? pk2(v[2], v[3]) : 0u;
                *(LAS u32x2*)(AoT + j * 144 + i0 * 2) = w;
            }
        } else {
            const int w4 = wave - 4, ib = w4 >> 1, jb = w4 & 1;
            f32x16 acc;
#pragma unroll
            for (int x = 0; x < 16; ++x) acc[x] = 0.f;
            if (!(ib == 0 && jb == 1)) {
#pragma unroll
                for (int s = 0; s < 8; ++s) { const bf16x8 a = ldf(Kt, jb * 32 + l31, 272, s * 32 + h32 * 16), bq = ldf(Qt, ib * 32 + l31, 272, s * 32 + h32 * 16); acc = MFMA32(a, bq, acc); }
            }
            const int i = ib * 32 + l31; const float gi = gcs[i];
            bf16* dst = B.INTRA + (size_t)item * 4096 + i * 64 + jb * 32;
#pragma unroll
            for (int q = 0; q < 4; ++q) {
                float v[4];
#pragma unroll
                for (int k = 0; k < 4; ++k) { const int j = jb * 32 + 8 * q + 4 * h32 + k; const float t = acc[4 * q + k] * __expf(gi - gcs[j]); v[k] = (i >= j) ? t : 0.f; }
                u32x2 w; w.x = pk2(v[0], v[1]); w.y = pk2(v[2], v[3]);
                *(u32x2*)(dst + 8 * q + 4 * h32) = w;
            }
        }
        {
            const int rr = tid >> 2, sg = tid & 3;
            const int xs = (rr >> 4) & 7;
            const u32x4 a = *(const LAS u32x4*)(KdT + rr * 144 + ((2 * sg) ^ xs) * 16), c = *(const LAS u32x4*)(KdT + rr * 144 + ((2 * sg + 1) ^ xs) * 16);
            bf16* d = B.KDT + (size_t)item * 8192 + rr * 64 + sg * 16;
            *(u32x4*)d = a; *(u32x4*)(d + 8) = c;
        }
        __syncthreads(); REOPQ;
        if (wave == 0) {
            const int blk = lane >> 4, c = lane & 15;
            const LAS float* Ab = Am + (16 * blk) * 68 + 16 * blk;
            float Dc[16];
            f32x4 rb[2][4];
            rb[1][0] = *(const LAS f32x4*)(Ab + 68);
            Dc[0] = (c == 0) ? 1.f : 0.f;
#pragma unroll
            for (int i = 1; i < 16; ++i) {
                if (i + 1 < 16) {
#pragma unroll
                    for (int q = 0; q <= i / 4; ++q) rb[(i + 1) & 1][q] = *(const LAS f32x4*)(Ab + (i + 1) * 68 + 4 * q);
                }
                float s0 = (i == c) ? 1.f : 0.f, s1 = 0.f;
#pragma unroll
                for (int j = 0; j < i; ++j) { if (j & 1) s1 -= rb[i & 1][j >> 2][j & 3] * Dc[j]; else s0 -= rb[i & 1][j >> 2][j & 3] * Dc[j]; }
                Dc[i] = s0 + s1;
            }
            u32x4 w0, w1;
            w0.x = pk2(Dc[0], Dc[1]); w0.y = pk2(Dc[2], Dc[3]); w0.z = pk2(Dc[4], Dc[5]); w0.w = pk2(Dc[6], Dc[7]);
            w1.x = pk2(Dc[8], Dc[9]); w1.y = pk2(Dc[10], Dc[11]); w1.z = pk2(Dc[12], Dc[13]); w1.w = pk2(Dc[14], Dc[15]);
            *(LAS u32x4*)(DmT + (16 * blk + c) * 144 + 32 * blk) = w0; *(LAS u32x4*)(DmT + (16 * blk + c) * 144 + 32 * blk + 16) = w1;
            {
                const unsigned ww[8] = {w0.x, w0.y, w0.z, w0.w, w1.x, w1.y, w1.z, w1.w};
#pragma unroll
                for (int i = 0; i < 16; i += 2) { *(LAS bf16*)(Dm + (16 * blk + i) * 144 + (16 * blk + c) * 2) = (bf16)(ww[i >> 1] & 0xffffu); *(LAS bf16*)(Dm + (16 * blk + i + 1) * 144 + (16 * blk + c) * 2) = (bf16)(ww[i >> 1] >> 16); }
            }
        }
        __syncthreads(); REOPQ;
        {
            const int o = wave >> 2, mb = (wave >> 1) & 1, nb = wave & 1;
            f32x16 acc;
#pragma unroll
            for (int x = 0; x < 16; ++x) acc[x] = 0.f;
            if (o == 0) {
#pragma unroll
                for (int s = 0; s < 4; ++s) { const bf16x8 a = ldf(Dm, mb * 32 + l31, 144, s * 32 + h32 * 16), bq = ldf(AoT, nb * 32 + l31, 144, s * 32 + h32 * 16); acc = MFMA32(a, bq, acc); }
#pragma unroll
                for (int q = 0; q < 4; ++q) { u32x2 w; w.x = pk2(acc[4 * q], acc[4 * q + 1]); w.y = pk2(acc[4 * q + 2], acc[4 * q + 3]);
                    *(LAS u32x2*)(NT + (nb * 32 + l31) * 144 + (mb * 32 + 8 * q + 4 * h32) * 2) = w; }
            } else {
#pragma unroll
                for (int s = 0; s < 4; ++s) { const bf16x8 a = ldf(AoT, nb * 32 + l31, 144, s * 32 + h32 * 16), bq = ldf(Dm, mb * 32 + l31, 144, s * 32 + h32 * 16); acc = MFMA32(a, bq, acc); }
                const int m = mb * 32 + l31;
#pragma unroll
                for (int q = 0; q < 4; ++q) {
                    const int n0 = nb * 32 + 8 * q + 4 * h32;
                    u32x2 w; w.x = pk2(acc[4 * q], acc[4 * q + 1]); w.y = pk2(acc[4 * q + 2], acc[4 * q + 3]);
                    *(LAS u32x2*)(Nm + m * 144 + n0 * 2) = w;
                    u32x2 z; z.x = pk2((m == n0 ? 1.f : 0.f) - acc[4 * q], (m == n0 + 1 ? 1.f : 0.f) - acc[4 * q + 1]); z.y = pk2((m == n0 + 2 ? 1.f : 0.f) - acc[4 * q + 2], (m == n0 + 3 ? 1.f : 0.f) - acc[4 * q + 3]);
                    *(LAS u32x2*)(INm + m * 144 + n0 * 2) = z;
                }
            }
        }
        __syncthreads(); REOPQ;
        if (wave < 4) {
            const int mb = wave >> 1, nb = wave & 1;
            f32x16 acc;
#pragma unroll
            for (int x = 0; x < 16; ++x) acc[x] = 0.f;
#pragma unroll
            for (int s = 0; s < 4; ++s) { const bf16x8 a = ldf(Nm, mb * 32 + l31, 144, s * 32 + h32 * 16), bq = ldf(NT, nb * 32 + l31, 144, s * 32 + h32 * 16); acc = MFMA32(a, bq, acc); }
            const int n = nb * 32 + l31;
#pragma unroll
            for (int q = 0; q < 4; ++q) {
                const int m0 = mb * 32 + 8 * q + 4 * h32;
                u32x2 w; w.x = pk2(acc[4 * q] + (n == m0 ? 1.f : 0.f), acc[4 * q + 1] + (n == m0 + 1 ? 1.f : 0.f)); w.y = pk2(acc[4 * q + 2] + (n == m0 + 2 ? 1.f : 0.f), acc[4 * q + 3] + (n == m0 + 3 ? 1.f : 0.f));
                *(LAS u32x2*)(ZT + n * 144 + m0 * 2) = w;
            }
        }
        __syncthreads(); REOPQ;
        if (wave < 4) {
            const int mb = wave >> 1, nb = wave & 1;
            f32x16 acc;
#pragma unroll
            for (int x = 0; x < 16; ++x) acc[x] = 0.f;
#pragma unroll
            for (int s = 0; s < 4; ++s) { const bf16x8 a = ldf(ZT, nb * 32 + l31, 144, s * 32 + h32 * 16), bq = ldf(INm, mb * 32 + l31, 144, s * 32 + h32 * 16); acc = MFMA32(a, bq, acc); }
#pragma unroll
            for (int q = 0; q < 4; ++q) { u32x2 w; w.x = pk2(acc[4 * q], acc[4 * q + 1]); w.y = pk2(acc[4 * q + 2], acc[4 * q + 3]);
                *(LAS u32x2*)(Pm + (mb * 32 + l31) * 144 + (nb * 32 + 8 * q + 4 * h32) * 2) = w; }
        }
        __syncthreads(); REOPQ;
        if (wave < 4) {
            const int ib = wave >> 1, jb = wave & 1;
            f32x16 acc;
#pragma unroll
            for (int x = 0; x < 16; ++x) acc[x] = 0.f;
#pragma unroll
            for (int s = 0; s < 4; ++s) { const bf16x8 a = ldf(DmT, jb * 32 + l31, 144, s * 32 + h32 * 16), bq = ldf(Pm, ib * 32 + l31, 144, s * 32 + h32 * 16); acc = MFMA32(a, bq, acc); }
#pragma unroll
            for (int q = 0; q < 4; ++q) { u32x2 w; w.x = pk2(acc[4 * q], acc[4 * q + 1]); w.y = pk2(acc[4 * q + 2], acc[4 * q + 3]);
                *(LAS u32x2*)(Tm + (ib * 32 + l31) * 144 + (jb * 32 + 8 * q + 4 * h32) * 2) = w; }
        }
        __syncthreads(); REOPQ;
        {
            const int ib = wave >> 2, chb = wave & 3;
            f32x16 aU, aW;
#pragma unroll
            for (int x = 0; x < 16; ++x) { aU[x] = 0.f; aW[x] = 0.f; }
#pragma unroll
            for (int s = 0; s < 4; ++s) {
                const int kc = ((2 * s + h32) ^ (chb * 2 + (l31 >> 4))) & 7;
                const bf16x8 tf = ldf(Tm, ib * 32 + l31, 144, s * 32 + h32 * 16), vf = ldf(VbT, chb * 32 + l31, 144, kc * 16), kf = ldf(KgT, chb * 32 + l31, 144, kc * 16);
                aU = MFMA32(tf, vf, aU); aW = MFMA32(kf, tf, aW);
            }
#pragma unroll
            for (int q = 0; q < 4; ++q) {
                u32x2 w; w.x = pk2(aU[4 * q], aU[4 * q + 1]); w.y = pk2(aU[4 * q + 2], aU[4 * q + 3]);
                *(LAS u32x2*)(KdT + (chb * 32 + l31) * 144 + (ib * 32 + 8 * q + 4 * h32) * 2) = w;
                u32x2 z; z.x = pk2(aW[4 * q], aW[4 * q + 1]); z.y = pk2(aW[4 * q + 2], aW[4 * q + 3]);
                *(LAS u32x2*)(Kt + (ib * 32 + l31) * 272 + (chb * 32 + 8 * q + 4 * h32) * 2) = z;
            }
        }
        __syncthreads(); REOPQ;
        {
            const int ru = tid >> 2, su = tid & 3;
            const u32x4 a0 = *(const LAS u32x4*)(KdT + ru * 144 + su * 32), a1 = *(const LAS u32x4*)(KdT + ru * 144 + su * 32 + 16);
            bf16* ud = B.UT + (size_t)item * 8192 + ru * 64 + su * 16;
            *(u32x4*)ud = a0; *(u32x4*)(ud + 8) = a1;
            const int rw = tid >> 3, sw = tid & 7;
            const u32x4 c0 = *(const LAS u32x4*)(Kt + rw * 272 + sw * 32), c1 = *(const LAS u32x4*)(Kt + rw * 272 + sw * 32 + 16);
            bf16* wd = B.W + (size_t)item * 8192 + rw * 128 + sw * 16;
            *(u32x4*)wd = c0; *(u32x4*)(wd + 8) = c1;
        }
#pragma unroll
        for (int q = 0; q < 2; ++q) {
            const unsigned u = xu + (unsigned)q, e = xgid + u * xnthr; DN_XDEC(e);
            if (u < xsteps && need) {
                u32x4 w; w.x = pk2(xa[q][0], xa[q][1]); w.y = pk2(xa[q][2], xa[q][3]); w.z = pk2(xc[q][0], xc[q][1]); w.w = pk2(xc[q][2], xc[q][3]);
                if (!ok) w = (u32x4){0u, 0u, 0u, 0u};
                *(u32x4*)(TF + ((size_t)g * 1024 + n) * UGX_LD + ck * 8) = w;
            }
        }
        xu += 2;
        __syncthreads(); REOPQ;
    }
    for (; xu < xsteps; ++xu) {
        const unsigned e = xgid + xu * xnthr; DN_XDEC(e);
        if (need) {
            const float* src = KTAB + ((size_t)g * 64 + (ok ? i - j : 0)) * 256 + h * 16 + hp0;
            const f32x4 a = *(const f32x4*)src, c = *(const f32x4*)(src + 4);
            u32x4 w; w.x = pk2(a[0], a[1]); w.y = pk2(a[2], a[3]); w.z = pk2(c[0], c[1]); w.w = pk2(c[2], c[3]);
            if (!ok) w = (u32x4){0u, 0u, 0u, 0u};
            *(u32x4*)(TF + ((size_t)g * 1024 + n) * UGX_LD + ck * 8) = w;
        }
    }
#undef DN_XDEC
#undef REOPQ
#undef DN_LOAD_RAW
}

__device__ __forceinline__ void dn_scan(LAS unsigned char* lds, const Ptrs& P, int l, const DnBufs& B) {
    const int BID = opaque_bid(), GRD = opaque_grid(); (void)BID; (void)GRD;
    LAS unsigned char* Wt = lds;
    LAS unsigned char* QGt = Wt + 17408;
    LAS unsigned char* KdT = QGt + 17408;
    LAS unsigned char* It = KdT + 18432;
    LAS unsigned char* UTt = It + 9216;
    LAS unsigned char* ST = UTt + 18432;
    LAS unsigned char* VnT = ST + 34816;
    LAS float* osq = (LAS float*)(VnT + 18432);
    const int nb = GRD / 2;
    if (BID >= nb) return;
    const int tid = opaque_tid(), wave = __builtin_amdgcn_readfirstlane(tid >> 6), lane = tid & 63, h32 = lane >> 5, l31 = lane & 31;
    for (int bh = BID; bh < BATCH * NH; bh += nb) {
        const int b = bh >> 2, hh = bh & 3;
        f32x16 Sacc[2];
#pragma unroll
        for (int x = 0; x < 16; ++x) { Sacc[0][x] = 0.f; Sacc[1][x] = 0.f; }
        for (int e = tid; e < 34816 / 16; e += NTHREADS) *(LAS u32x4*)(ST + e * 16) = (u32x4){0u, 0u, 0u, 0u};
        const int r8 = tid >> 3, s8 = tid & 7, r4 = tid >> 2, s4 = tid & 3;
        u32x4 pw0, pw1, pq0, pq1, pk0, pk1, pu0, pu1, pi0;
        {
            const size_t it0 = (size_t)bh * 32;
            const bf16* wsrc_ = B.W + it0 * 8192 + r8 * 128 + s8 * 16; pw0 = *(const u32x4*)wsrc_; pw1 = *(const u32x4*)(wsrc_ + 8);
            const bf16* qsrc_ = B.QG + it0 * 8192 + r8 * 128 + s8 * 16; pq0 = *(const u32x4*)qsrc_; pq1 = *(const u32x4*)(qsrc_ + 8);
            const bf16* ksrc_ = B.KDT + it0 * 8192 + r4 * 64 + s4 * 16; pk0 = *(const u32x4*)ksrc_; pk1 = *(const u32x4*)(ksrc_ + 8);
            const bf16* usrc_ = B.UT + it0 * 8192 + r4 * 64 + s4 * 16; pu0 = *(const u32x4*)usrc_; pu1 = *(const u32x4*)(usrc_ + 8);
            pi0 = *(const u32x4*)(B.INTRA + it0 * 4096 + r8 * 64 + s8 * 8);
        }
        const int ib = wave >> 2, dvb = wave & 3;
        f32x4 ngv[4];
        __builtin_amdgcn_sched_barrier(0);
        { int z0 = 0; asm volatile("" : "+s"(z0));
#pragma unroll
          for (int q = 0; q < 4; ++q) ngv[q] = *(const f32x4*)(P.dn_g + l * 128 + dvb * 32 + 8 * q + 4 * h32 + z0); }
        float eg_next = B.GLAST[(size_t)bh * 32];
        __builtin_amdgcn_sched_barrier(0);
        for (int c = 0; c < 32; ++c) {
            const size_t item = (size_t)bh * 32 + c;
            *(LAS u32x4*)(Wt + r8 * 272 + s8 * 32) = pw0; *(LAS u32x4*)(Wt + r8 * 272 + s8 * 32 + 16) = pw1;
            *(LAS u32x4*)(QGt + r8 * 272 + s8 * 32) = pq0; *(LAS u32x4*)(QGt + r8 * 272 + s8 * 32 + 16) = pq1;
            *(LAS u32x4*)(KdT + r4 * 144 + s4 * 32) = pk0; *(LAS u32x4*)(KdT + r4 * 144 + s4 * 32 + 16) = pk1;
            *(LAS u32x4*)(UTt + r4 * 144 + s4 * 32) = pu0; *(LAS u32x4*)(UTt + r4 * 144 + s4 * 32 + 16) = pu1;
            *(LAS u32x4*)(It + r8 * 144 + s8 * 16) = pi0;
            const float eg = eg_next;
            __syncthreads();
            eg_next = B.GLAST[c + 1 < 32 ? item + 1 : item];
            u32x2 zq[4];
            {
                const size_t rowz = (size_t)b * SEQ + c * 64 + ib * 32 + l31;
#pragma unroll
                for (int q = 0; q < 4; ++q) zq[q] = *(const u32x2*)(P.ZDN + rowz * 512 + hh * 128 + dvb * 32 + 8 * q + 4 * h32);
            }
            constexpr bool pf_ = true; const size_t it1 = c + 1 < 32 ? item + 1 : item;
            f32x16 oacc;
            {
                f32x16 acc;
#pragma unroll
                for (int x = 0; x < 16; ++x) { acc[x] = 0.f; oacc[x] = 0.f; }
#pragma unroll
                for (int s = 0; s < 8; ++s) {
                    const bf16x8 a = ldf(Wt, ib * 32 + l31, 272, s * 32 + h32 * 16), bq = ldf(ST, dvb * 32 + l31, 272, s * 32 + h32 * 16), qf = ldf(QGt, ib * 32 + l31, 272, s * 32 + h32 * 16);
                    if (pf_) {
                        if (s == 0) pw0 = *(const u32x4*)(B.W + it1 * 8192 + r8 * 128 + s8 * 16);
                        if (s == 1) pw1 = *(const u32x4*)(B.W + it1 * 8192 + r8 * 128 + s8 * 16 + 8);
                        if (s == 2) pq0 = *(const u32x4*)(B.QG + it1 * 8192 + r8 * 128 + s8 * 16);
                        if (s == 3) pq1 = *(const u32x4*)(B.QG + it1 * 8192 + r8 * 128 + s8 * 16 + 8);
                        if (s == 4) pk0 = *(const u32x4*)(B.KDT + it1 * 8192 + r4 * 64 + s4 * 16);
                        if (s == 5) pk1 = *(const u32x4*)(B.KDT + it1 * 8192 + r4 * 64 + s4 * 16 + 8);
                        if (s == 6) { pu0 = *(const u32x4*)(B.UT + it1 * 8192 + r4 * 64 + s4 * 16); pu1 = *(const u32x4*)(B.UT + it1 * 8192 + r4 * 64 + s4 * 16 + 8); }
                        if (s == 7) pi0 = *(const u32x4*)(B.INTRA + it1 * 4096 + r8 * 64 + s8 * 8);
                    }
                    acc = MFMA32(a, bq, acc); oacc = MFMA32(bq, qf, oacc);
                    __builtin_amdgcn_sched_barrier(0);
                }
                const int dv = dvb * 32 + l31;
#pragma unroll
                for (int q = 0; q < 4; ++q) {
                    const int i0 = ib * 32 + 8 * q + 4 * h32;
                    const u32x2 u = *(const LAS u32x2*)(UTt + dv * 144 + i0 * 2);
                    const float v0 = bf2f((bf16)(u.x & 0xffff)) - acc[4 * q], v1 = bf2f((bf16)(u.x >> 16)) - acc[4 * q + 1], v2 = bf2f((bf16)(u.y & 0xffff)) - acc[4 * q + 2], v3 = bf2f((bf16)(u.y >> 16)) - acc[4 * q + 3];
                    u32x2 w; w.x = pk2(v0, v1); w.y = pk2(v2, v3);
                    *(LAS u32x2*)(VnT + dv * 144 + i0 * 2) = w;
                }
            }
            __syncthreads();
            {
#pragma unroll
                for (int s = 0; s < 4; ++s) { const bf16x8 a = ldf(VnT, dvb * 32 + l31, 144, s * 32 + h32 * 16), bq = ldf(It, ib * 32 + l31, 144, s * 32 + h32 * 16); oacc = MFMA32(a, bq, oacc); }
                float ss = 0.f;
#pragma unroll
                for (int x = 0; x < 16; ++x) ss += oacc[x] * oacc[x];
                osq[(dvb * 2 + h32) * 64 + ib * 32 + l31] = ss;
            }
            {
                const int dkb = wave & 3;
#pragma unroll
                for (int t = 0; t < 2; ++t) {
#pragma unroll
                    for (int x = 0; x < 16; ++x) Sacc[t][x] *= eg;
                }
#pragma unroll
                for (int s = 0; s < 4; ++s) {
                    const bf16x8 a = ldf(KdT, dkb * 32 + l31, 144, s * 32 + h32 * 16);
                    const bf16x8 b0 = ldf(VnT, (2 * (wave >> 2)) * 32 + l31, 144, s * 32 + h32 * 16), b1 = ldf(VnT, (2 * (wave >> 2) + 1) * 32 + l31, 144, s * 32 + h32 * 16);
                    Sacc[0] = MFMA32(a, b0, Sacc[0]); Sacc[1] = MFMA32(a, b1, Sacc[1]);
                }
            }
            __syncthreads();
            {
                const int i = ib * 32 + l31;
                const float tot = ((osq[i] + osq[64 + i]) + (osq[128 + i] + osq[192 + i])) + ((osq[256 + i] + osq[320 + i]) + (osq[384 + i] + osq[448 + i]));
                const float rinv = __builtin_amdgcn_rsqf(tot * (1.f / 128.f) + EPS);
                const size_t row = (size_t)b * SEQ + c * 64 + i;
#pragma unroll
                for (int q = 0; q < 4; ++q) {
                    const int dv0 = dvb * 32 + 8 * q + 4 * h32;
                    const u32x2 z = zq[q];
                    const f32x4 ng = ngv[q];
                    const float o0 = oacc[4 * q] * rinv * ng[0] * bf2f((bf16)(z.x & 0xffff)), o1 = oacc[4 * q + 1] * rinv * ng[1] * bf2f((bf16)(z.x >> 16));
                    const float o2 = oacc[4 * q + 2] * rinv * ng[2] * bf2f((bf16)(z.y & 0xffff)), o3 = oacc[4 * q + 3] * rinv * ng[3] * bf2f((bf16)(z.y >> 16));
                    u32x2 w; w.x = pk2(o0, o1); w.y = pk2(o2, o3);
                    *(u32x2*)(P.MIXIN + row * D + hh * 128 + dv0) = w;
                }
            }
            {
                const int dkb = wave & 3;
#pragma unroll
                for (int t = 0; t < 2; ++t) {
                    const int dv = (2 * (wave >> 2) + t) * 32 + l31;
#pragma unroll
                    for (int q = 0; q < 4; ++q) {
                        u32x2 w; w.x = pk2(Sacc[t][4 * q], Sacc[t][4 * q + 1]); w.y = pk2(Sacc[t][4 * q + 2], Sacc[t][4 * q + 3]);
                        *(LAS u32x2*)(ST + dv * 272 + (dkb * 32 + 8 * q + 4 * h32) * 2) = w;
                    }
                }
            }
        }
        __syncthreads();
    }
}

#define XB_TMO      128
#define XB_XCNT(j)  (256  + 64 * (j))
#define XB_XSUB(j)  (1280 + 64 * (j))
#define XB_XGEN(j)  (2304 + 64 * (j))
#define XB_TOP      3328
#define XB_TOPGEN   3392
#define XCD_BAR_WORDS 3456
#define XB_SPIN_CAP (1u << 18)
__device__ __forceinline__ unsigned xb_ld(unsigned* p)              { return __hip_atomic_load(p, __ATOMIC_RELAXED, __HIP_MEMORY_SCOPE_AGENT); }
__device__ __forceinline__ unsigned xb_add(unsigned* p, unsigned v) { return __hip_atomic_fetch_add(p, v, __ATOMIC_RELAXED, __HIP_MEMORY_SCOPE_AGENT); }
__device__ __forceinline__ unsigned xb_xcc_id() { return (unsigned)__builtin_amdgcn_s_getreg((3 << 11) | 20) & 0xFu; }
#define XB_SPIN(cond, bar) do { unsigned _sp = 0; while (cond) { __builtin_amdgcn_s_sleep(1); \
    if ((++_sp & 255u) == 0u) { if (xb_ld(&(bar)[XB_TMO])) break; if (_sp > XB_SPIN_CAP) { atomicAdd(&(bar)[XB_TMO], 1u); break; } } } } while (0)
struct XcdBarrier { unsigned* bar; unsigned x; volatile LAS unsigned* st; };
__device__ __forceinline__ XcdBarrier xcd_barrier_post(unsigned* bar, volatile LAS unsigned* st) {
    XcdBarrier b; b.bar = bar; b.x = xb_xcc_id(); b.st = st;
    if (threadIdx.x == 0) (void)xb_add(&bar[XB_XCNT(b.x)], 1u);
    return b;
}
__device__ __forceinline__ void xcd_barrier_complete(unsigned* bar, unsigned x, unsigned& nloc, unsigned& nx) {
    const unsigned G = gridDim.x * gridDim.y * gridDim.z;
    unsigned sum, cnt, mine, sp = 0u;
    for (;;) {
        sum = 0u; cnt = 0u; mine = 0u;
#pragma unroll
        for (unsigned j = 0; j < 16; ++j) { const unsigned c = xb_ld(&bar[XB_XCNT(j)]); sum += c; cnt += (c > 0u) ? 1u : 0u; mine = (j == x) ? c : mine; }
        if (sum == G) break;
        __builtin_amdgcn_s_sleep(1);
        if ((++sp & 255u) == 0u) { if (xb_ld(&bar[XB_TMO])) break; if (sp > XB_SPIN_CAP) { atomicAdd(&bar[XB_TMO], 1u); break; } }
    }
    nloc = mine > 0u ? mine : 1u; nx = cnt > 0u ? cnt : 1u;
}
__device__ __forceinline__ void xcd_barrier(const XcdBarrier& b) {
    asm volatile("s_waitcnt vmcnt(0)" ::: "memory");
    __syncthreads();
    if (threadIdx.x == 0) {
        unsigned* bar = b.bar;
        __builtin_amdgcn_s_waitcnt(0);
        unsigned nloc = b.st[0], nx = b.st[1];
        if (nloc == 0u) { xcd_barrier_complete(bar, b.x, nloc, nx); b.st[0] = nloc; b.st[1] = nx; }
        const unsigned old = xb_add(&bar[XB_XSUB(b.x)], 1u);
        const unsigned gen = old / nloc;
        if (old + 1u == (gen + 1u) * nloc) {
            __builtin_amdgcn_fence(__ATOMIC_RELEASE, "agent");
            asm volatile("s_waitcnt vmcnt(0)" ::: "memory");
            const unsigned og = xb_add(&bar[XB_TOP], 1u);
            const unsigned tg = og / nx;
            if (og + 1u == (tg + 1u) * nx) xb_add(&bar[XB_TOPGEN], 1u);
            else XB_SPIN(xb_ld(&bar[XB_TOPGEN]) == tg, bar);
            __builtin_amdgcn_fence(__ATOMIC_ACQUIRE, "agent");
            xb_add(&bar[XB_XGEN(b.x)], 1u);
            asm volatile("s_waitcnt vmcnt(0)" ::: "memory");
        } else {
            XB_SPIN(xb_ld(&bar[XB_XGEN(b.x)]) == gen, bar);
            __builtin_amdgcn_fence(__ATOMIC_ACQUIRE, "agent");
            asm volatile("s_waitcnt vmcnt(0)" ::: "memory");
        }
    }
    __syncthreads();
}

typedef const __attribute__((address_space(4))) Args* KArgs;
#define MKP const int BID = opaque_bid(), GRD = opaque_grid(); (void)BID; (void)GRD; Ptrs P; unsigned char* ws; { KArgs ap = (KArgs)__builtin_amdgcn_kernarg_segment_ptr(); asm volatile("" : "+s"(ap)); \
    P.x = ap->in[0]; P.pre_g = ap->in[1]; P.post_g = ap->in[2]; P.w_in = ap->in[3]; P.conv_w = ap->in[4]; P.a_log = ap->in[5]; P.dt_bias = ap->in[6]; P.dn_g = ap->in[7]; \
    P.a_re = ap->in[8]; P.a_im = ap->in[9]; P.b_re = ap->in[10]; P.b_im = ap->in[11]; P.c_re = ap->in[12]; P.c_im = ap->in[13]; P.sd = ap->in[14]; P.log_dt = ap->in[15]; \
    P.glu_w = ap->in[16]; P.glu_b = ap->in[17]; P.w_out = ap->in[18]; P.out = ap->out; ws = ap->ws; \
    P.XN = (bf16*)(ws + WS_XN); P.MIXIN = P.XN; P.QKVR = (bf16*)(ws + WS_QKV); P.MIXO = (bf16*)(ws + WS_MIXO); P.YS = (bf16*)(ws + WS_YS); \
    P.ZDN = (bf16*)(ws + WS_ZDN); P.ZS = (bf16*)(ws + WS_ZS); P.UGX = (bf16*)(ws + WS_UGX); \
    P.BETA = (float*)(ws + WS_BETA); P.GLOG = (float*)(ws + WS_GLOG); P.SSQ = (float*)(ws + WS_SSQ); } \
    const DnBufs DB{(bf16*)(ws + WS_DNUT), (bf16*)(ws + WS_DNW), (bf16*)(ws + WS_DNQG), (bf16*)(ws + WS_DNKD), (bf16*)(ws + WS_DNIN), (float*)(ws + WS_GLAST)}; \
    bf16* const TF = (bf16*)(ws + WS_TF); bf16* const WE = (bf16*)(ws + WS_WE); float* const EST = (float*)(ws + WS_EST); float* const KTAB = (float*)(ws + WS_KTAB); (void)DB; (void)TF; (void)WE; (void)EST; (void)KTAB;
#define KARG() ({ KArgs ap_ = (KArgs)__builtin_amdgcn_kernarg_segment_ptr(); asm volatile("" : "+s"(ap_)); ap_; })
#define IN(k) ({ KArgs q_ = KARG(); q_->lo <= (k) && (k) < q_->hi; })
#define SEAM(k) do { if (IN(k) && IN((k) + 1)) { { KArgs q2_ = KARG(); XcdBarrier xb_; xb_.bar = (unsigned*)(q2_->ws + WS_CTL) + 1024; xb_.x = xb_xcc_id(); \
        xb_.st = (volatile LAS unsigned*)((LAS unsigned char*)lds + MISC_OFF) + 8; xcd_barrier(xb_); } } } while (0)
template <int l>
__device__ __forceinline__ void layer_phases(unsigned char* lds, cg::grid_group& grid) {
        for (int rep_ = 0; rep_ < (PROBE_REP == 0 ? 2 : 1); ++rep_) if (IN(NPH * l + 0)) {
            MKP
            if (l == 0) { prologue_weights((LAS unsigned char*)lds, P, ws); p0_norm((LAS unsigned char*)lds, P, 0, 0, P.x, nullptr, nullptr, P.pre_g); }
            else p0_norm((LAS unsigned char*)lds, P, l, 1, l == 1 ? P.x : P.out, P.out, P.post_g + (l - 1) * D, P.pre_g + l * D);
#if FAST_S5
            s5_build((LAS unsigned char*)lds, P, l, TF, WE, KTAB);
#endif
        }
        SEAM(NPH * l + 0);
        for (int rep_ = 0; rep_ < (PROBE_REP == 1 ? 2 : 1); ++rep_) if (IN(NPH * l + 1)) {
            MKP
#if FAST_P1
            pg8::Gemm g{P.XN, (const bf16*)(ws + WS_WIN) + (size_t)l * 3072 * D, D, D, D, 1 << 20};
            pg8::StaticOrder S; S.init(T, 3072, GRD, BID);
            EpiInProj E{P.QKVR, P.ZDN, P.ZS, P.UGX, P.BETA, P.GLOG, P.a_log + l * 4, P.dt_bias + l * 4};
            pg8::gemm_phase<EpiInProj, pg8::StaticOrder>((LAS unsigned char*)lds, g, S, E);
#else
            ngemm<0>(lds, P, l, P.XN, D, P.w_in + (size_t)l * D * INC, INC, INC, D);
#endif
        }
        SEAM(NPH * l + 1);
        for (int rep_ = 0; rep_ < (PROBE_REP == 2 ? 2 : 1); ++rep_) if (IN(NPH * l + 2)) {
            MKP
#if FAST_DN
            dn_chunk((LAS unsigned char*)lds, P, l, DB, TF, KTAB);
#endif
        }
        SEAM(NPH * l + 2);
        for (int rep_ = 0; rep_ < (PROBE_REP == 3 ? 2 : 1); ++rep_) if (IN(NPH * l + 3)) {
            MKP
#if FAST_DN
            dn_scan((LAS unsigned char*)lds, P, l, DB);
#else
            dn_naive(lds, P, l);
#endif
#if FAST_S5
            {
                const int nb = GRD / 2, c0 = BID - nb, cnt = GRD - nb;
                const int c = (c0 >= 0 && (cnt & 7) == 0) ? (c0 & 7) * (cnt >> 3) + (c0 >> 3) : c0;
                if (c >= 0) {
                    {
                        pg8::Gemm ge{P.UGX, WE, UGX_LD, 1024, 1024, 4};
                        S5EOrder SE{1, cnt, c};
                        EpiEst EE{EST};
                        pg8::gemm_phase<EpiEst, S5EOrder>((LAS unsigned char*)lds, ge, SE, EE);
                        asm volatile("s_waitcnt vmcnt(0)" ::: "memory");
                        __syncthreads();
                    }
                    const int tid = opaque_tid();
                    for (int pm = c; pm < NG * 4; pm += cnt) s5_carry(P, l, pm, EST, P.UGX, tid);
                    asm volatile("s_waitcnt vmcnt(0)" ::: "memory");
                    __syncthreads();
                    pg8::Gemm g{P.UGX, TF, UGX_LD, UGX_LD, UGX_LD, 4};
                    S5Order S{4, cnt, c};
                    EpiS5 E{P.YS};
                    pg8::gemm_phase<EpiS5, S5Order>((LAS unsigned char*)lds, g, S, E);
                }
            }
#else
            s5_naive(P, l);
#endif
        }
        SEAM(NPH * l + 3);
        for (int rep_ = 0; rep_ < (PROBE_REP == 4 ? 2 : 1); ++rep_) if (IN(NPH * l + 4)) {
            MKP
#if FAST_P3
            pg8::Gemm g{P.YS, (const bf16*)(ws + WS_WGLU) + (size_t)l * 1024 * SW, SW, SW, SW, 1 << 20};
            pg8::StaticOrder S; S.init(T, 1024, GRD, BID);
            EpiGlu E{P.MIXIN, P.ZS, P.glu_b + l * 1024};
            pg8::gemm_phase<EpiGlu, pg8::StaticOrder>((LAS unsigned char*)lds, g, S, E);
#else
            ngemm<1>(lds, P, l, P.YS, SW, P.glu_w + (size_t)l * SW * 1024, 1024, 512, SW);
#endif
        }
        SEAM(NPH * l + 4);
        for (int rep_ = 0; rep_ < (PROBE_REP == 5 ? 2 : 1); ++rep_) if (IN(NPH * l + 5)) {
            MKP
#if FAST_P4
            pg8::Gemm g{P.MIXIN, (const bf16*)(ws + WS_WOUT) + (size_t)l * D * D, D, D, D, 1 << 20};
            pg8::StaticOrder S; S.init(T, D, GRD, BID);
            EpiOut E{P.MIXO, P.SSQ};
            pg8::gemm_phase<EpiOut, pg8::StaticOrder>((LAS unsigned char*)lds, g, S, E);
#else
            ngemm<2>(lds, P, l, P.MIXIN, D, P.w_out + (size_t)l * D * D, D, D, D);
#endif
        }
        SEAM(NPH * l + 5);
    }

__global__ void __launch_bounds__(NTHREADS, 2) fwd(Args a) {
    extern __shared__ __attribute__((aligned(16))) unsigned char lds[];
    cg::grid_group grid = cg::this_grid();
    volatile LAS unsigned* MISC = (volatile LAS unsigned*)((LAS unsigned char*)lds + MISC_OFF);
    if (threadIdx.x < 32) MISC[threadIdx.x] = 0u;
    __syncthreads();
    (void)xcd_barrier_post((unsigned*)(a.ws + WS_CTL) + 1024, MISC + 8);
    layer_phases<0>(lds, grid);
    layer_phases<1>(lds, grid);
    static_assert(DEPTH == 2, "two explicit layer instantiations");
    if (IN(NPH * DEPTH)) { MKP p0_norm((LAS unsigned char*)lds, P, 0, 2, P.out, P.out, P.post_g + (DEPTH - 1) * D, nullptr); }
#undef IN
#undef SEAM
}

extern "C" void kernel_launch(void* const* d_in, const int* in_sizes, int n_in, void* d_out, int out_size, void* d_ws, size_t ws_size, hipStream_t stream) {
    static int grid = 0;
    if (grid == 0) {
        if (n_in != 19 || in_sizes[0] != T * D || out_size != T * D || ws_size < WS_END) {
            fprintf(stderr, "kernel_launch: unexpected shapes/workspace: n_in %d in0 %d out %d ws %zu (need %zu)\n", n_in, n_in > 0 ? in_sizes[0] : -1, out_size, ws_size, (size_t)WS_END);
            grid = -1; return;
        }
        int dev = 0, cus = 0, per_cu = 0;
        hipGetDevice(&dev);
        hipDeviceGetAttribute(&cus, hipDeviceAttributeMultiprocessorCount, dev);
        hipFuncSetAttribute((const void*)fwd, hipFuncAttributeMaxDynamicSharedMemorySize, LDS_BYTES);
        hipOccupancyMaxActiveBlocksPerMultiprocessor(&per_cu, (const void*)fwd, NTHREADS, LDS_BYTES);
        if (per_cu < 1) { fprintf(stderr, "kernel_launch: occupancy query says %d blocks/CU\n", per_cu); per_cu = 1; }
        (void)hipGetLastError();
        grid = cus;
        fprintf(stderr, "kernel_launch: cus %d per_cu %d grid %d ws %zu\n", cus, per_cu, grid, ws_size);
    }
    if (grid < 0) return;
    if (hipMemsetAsync((char*)d_ws + WS_CTL, 0, CTL_ZERO_BYTES, stream) != hipSuccess) { fprintf(stderr, "kernel_launch: memset failed\n"); return; }
    Args a{};
    for (int i = 0; i < 19; ++i) a.in[i] = (const float*)d_in[i];
    a.out = (float*)d_out; a.ws = (unsigned char*)d_ws; a.lo = 0; a.hi = NPH * DEPTH + 1;
    void* args[] = {&a};
    hipError_t e = hipLaunchCooperativeKernel((const void*)fwd, dim3(grid), dim3(NTHREADS), args, LDS_BYTES, stream);
    if (e != hipSuccess) fprintf(stderr, "cooperative launch failed: %s (grid %d)\n", hipGetErrorString(e), grid);
}
```
